# Optimizing an MI355X kernel written in HIP

```python
import jax, jax.numpy as jnp
from jax import lax
import numpy as np

D_MODEL = 1024
BATCH = 2
SEQ = 8192
DEPTH = 1

CHUNK = 64
N_MEM = 256
A_HEADS = 8
A_HEAD_DIM = 64
KV_RANK = 128
IDX_HEADS = 8
IDX_DIM = 32
TOPK_MAX = 256
Q_BLOCK = 128
CONV_CH = 512
CONV_WIDTH = 31
C_HEADS = 4
C_HEAD_DIM = 128
N_BRANCH = 3
N_EXPERTS = 32
TOP_K = 4
D_EXPERT = 1024
SWIGLU_LIMIT = 7.0
SWIGLU_ALPHA = 1.702
MOE_BLOCK = 256

LN_EPS = 1e-5
NEG_INF = -1e30
A_SCALE = A_HEAD_DIM ** -0.5
IDX_SCALE = (IDX_HEADS * IDX_DIM) ** -0.5
C_SCALE = C_HEAD_DIM ** -0.5
DN_ALPHA = (2 * DEPTH) ** 0.25
DN_BETA = (8 * DEPTH) ** -0.25

SPLITS = (A_HEADS * A_HEAD_DIM, KV_RANK, IDX_HEADS * IDX_DIM, IDX_DIM, IDX_HEADS,
          2 * CONV_CH, C_HEADS * C_HEAD_DIM, N_BRANCH * D_MODEL)
D_IN = sum(SPLITS)

kernel_name = 'hybrid_dsa_conformer_memory_moe_deepnorm'


def _layer_norm(x, g, b):
    xf = x.astype(jnp.float32)
    xc = xf - jnp.mean(xf, -1, keepdims=True)
    var = jnp.mean(xc * xc, -1, keepdims=True)
    return (xc * lax.rsqrt(var + LN_EPS) * g.astype(jnp.float32) + b.astype(jnp.float32)).astype(x.dtype)


def _rms_norm(x, g):
    xf = x.astype(jnp.float32)
    return (xf * lax.rsqrt(jnp.mean(xf * xf, -1, keepdims=True) + LN_EPS) * g.astype(jnp.float32)).astype(x.dtype)


def _split_cols(a):
    parts, start = [], 0
    for width in SPLITS:
        parts.append(a[..., start:start + width])
        start += width
    return parts


def _alibi_slopes():
    return jnp.exp2(-(8.0 / A_HEADS) * jnp.arange(1, A_HEADS + 1, dtype=jnp.float32))


def _dsa_mla_attention(q_a, c_kv, q_idx, k_idx, w_idx, w_uk, w_uv):
    bsz, seq = c_kv.shape[:2]
    topk = min(TOPK_MAX, seq // 4)
    n_blocks = seq // Q_BLOCK
    q_lat = jnp.einsum('bthd,hrd->bthr', q_a, w_uk)
    key_chunk = jnp.arange(seq) // CHUNK
    slopes = _alibi_slopes()
    k_idx32 = k_idx.astype(jnp.float32)
    c_kv32 = c_kv.astype(jnp.float32)

    def to_blocks(a):
        return jnp.moveaxis(a.reshape(bsz, n_blocks, Q_BLOCK, *a.shape[2:]), 1, 0)

    def block(args):
        qi, wi, ql, blk = args
        q_pos = blk * Q_BLOCK + jnp.arange(Q_BLOCK)
        q_chunk = q_pos // CHUNK
        admissible = key_chunk[None, :] <= q_chunk[:, None]
        rel = jax.nn.relu(jnp.einsum('bqhd,bsd->bqhs', qi.astype(jnp.float32), k_idx32))
        score = jnp.einsum('bqhs,bqh->bqs', rel, wi.astype(jnp.float32) * IDX_SCALE)
        score = jnp.where(admissible[None], score, NEG_INF)
        _, sel = lax.top_k(score, topk)
        c_sel = jax.vmap(lambda c, i: c[i])(c_kv32, sel)
        valid = key_chunk[sel] <= q_chunk[None, :, None]
        dist = jnp.abs(q_pos[None, :, None] - sel).astype(jnp.float32)
        logits = (jnp.einsum('bqhr,bqkr->bqhk', ql.astype(jnp.float32), c_sel) * A_SCALE
                  - slopes[None, None, :, None] * dist[:, :, None, :])
        logits = jnp.where(valid[:, :, None, :], logits, NEG_INF)
        p = jax.nn.softmax(logits, axis=-1)
        return jnp.einsum('bqhk,bqkr->bqhr', p, c_sel).astype(ql.dtype)

    o_lat = lax.map(block, (to_blocks(q_idx), to_blocks(w_idx), to_blocks(q_lat), jnp.arange(n_blocks)))
    o_lat = jnp.moveaxis(o_lat, 0, 1).reshape(bsz, seq, A_HEADS, KV_RANK)
    return jnp.einsum('bthr,hrd->bthd', o_lat, w_uv).reshape(bsz, seq, A_HEADS * A_HEAD_DIM)


def _conformer_conv(glu_in, w_dw, b_dw, ln_g, ln_b, w_pw2, b_pw2):
    a, g = jnp.split(glu_in, 2, axis=-1)
    u = a * jax.nn.sigmoid(g)
    u = lax.conv_general_dilated(u, w_dw[:, None, :], window_strides=(1,),
                                 padding=[(CONV_WIDTH - 1, 0)],
                                 dimension_numbers=('NWC', 'WIO', 'NWC'),
                                 feature_group_count=CONV_CH) + b_dw
    u = jax.nn.silu(_layer_norm(u, ln_g, ln_b))
    return u @ w_pw2 + b_pw2


def _memory_attention(q_c, mem, w_mem_k, w_mem_v):
    bsz, seq = q_c.shape[:2]
    n_mem = mem.shape[1]
    q = q_c.reshape(bsz, seq, C_HEADS, C_HEAD_DIM).astype(jnp.float32)
    k = (mem @ w_mem_k).reshape(bsz, n_mem, C_HEADS, C_HEAD_DIM).astype(jnp.float32)
    v = (mem @ w_mem_v).reshape(bsz, n_mem, C_HEADS, C_HEAD_DIM).astype(jnp.float32)
    p = jax.nn.softmax(jnp.einsum('bthd,bmhd->bhtm', q, k) * C_SCALE, axis=-1)
    o = jnp.einsum('bhtm,bmhd->bthd', p, v)
    return o.reshape(bsz, seq, C_HEADS * C_HEAD_DIM).astype(q_c.dtype)


def _moe(x, w_router, b_router, w1, b1, w2, b2):
    bsz, seq, dm = x.shape
    n_tok = bsz * seq
    xt = x.reshape(n_tok, dm)
    logits = (xt @ w_router + b_router).astype(jnp.float32)
    top_v, top_e = lax.top_k(logits, TOP_K)
    gate = jax.nn.softmax(top_v, axis=-1)
    n_assign = n_tok * TOP_K
    flat_e = top_e.reshape(n_assign)
    flat_tok = jnp.arange(n_assign) // TOP_K
    flat_g = gate.reshape(n_assign)
    order = jnp.argsort(flat_e)
    sorted_e = flat_e[order]
    counts = jnp.bincount(flat_e, length=N_EXPERTS)
    padded = (counts + MOE_BLOCK - 1) // MOE_BLOCK * MOE_BLOCK
    pad_end = jnp.cumsum(padded)
    pad_start = pad_end - padded
    grp_start = jnp.cumsum(counts) - counts
    dest = pad_start[sorted_e] + jnp.arange(n_assign) - grp_start[sorted_e]
    n_blocks = -(-n_assign // MOE_BLOCK) + N_EXPERTS
    n_rows = n_blocks * MOE_BLOCK
    row_tok = jnp.full((n_rows,), n_tok, dtype=jnp.int32).at[dest].set(flat_tok[order])
    row_gate = jnp.zeros((n_rows,), jnp.float32).at[dest].set(flat_g[order])
    blk_exp = jnp.minimum(jnp.searchsorted(pad_end, jnp.arange(n_blocks) * MOE_BLOCK, side='right'),
                          N_EXPERTS - 1)
    x_pad = jnp.concatenate([xt, jnp.zeros((1, dm), xt.dtype)], axis=0)
    rows = x_pad[row_tok].reshape(n_blocks, MOE_BLOCK, dm)

    def expert_block(args):
        xb, e = args
        hdn = xb @ w1[e] + b1[e]
        g, u = jnp.split(hdn, 2, axis=-1)
        g = jnp.minimum(g, SWIGLU_LIMIT)
        u = jnp.clip(u, -SWIGLU_LIMIT, SWIGLU_LIMIT)
        return ((u + 1.0) * (g * jax.nn.sigmoid(SWIGLU_ALPHA * g))) @ w2[e] + b2[e]

    y = lax.map(expert_block, (rows, blk_exp)).reshape(n_rows, dm)
    y = y * row_gate[:, None].astype(y.dtype)
    out = jax.ops.segment_sum(y, row_tok, num_segments=n_tok + 1)[:n_tok]
    return out.reshape(bsz, seq, dm)


def setup_inputs(seed: int = 0) -> dict:
    key = jax.random.key(seed)
    ks = jax.random.split(key, 32)
    L = DEPTH
    a_w = A_HEADS * A_HEAD_DIM
    c_w = C_HEADS * C_HEAD_DIM

    def nrm(k, shape, scale):
        return scale * jax.random.normal(k, shape, jnp.float32)

    return {
        'x': nrm(ks[0], (BATCH, SEQ, D_MODEL), 1.0),
        'mem': nrm(ks[1], (BATCH, N_MEM, D_MODEL), 1.0),
        'ln0_g': 1.0 + nrm(ks[2], (D_MODEL,), 0.02),
        'ln0_b': nrm(ks[3], (D_MODEL,), 0.02),
        'w_in': nrm(ks[4], (L, D_MODEL, D_IN), D_MODEL ** -0.5),
        'b_in': nrm(ks[5], (L, D_IN), 0.02),
        'kv_norm_g': 1.0 + nrm(ks[6], (L, KV_RANK), 0.02),
        'w_uk': nrm(ks[7], (L, A_HEADS, KV_RANK, A_HEAD_DIM), KV_RANK ** -0.5),
        'w_uv': nrm(ks[8], (L, A_HEADS, KV_RANK, A_HEAD_DIM), DN_BETA * KV_RANK ** -0.5),
        'w_o_a': nrm(ks[9], (L, a_w, D_MODEL), DN_BETA * a_w ** -0.5),
        'w_dw': nrm(ks[10], (L, CONV_WIDTH, CONV_CH), CONV_WIDTH ** -0.5),
        'b_dw': nrm(ks[11], (L, CONV_CH), 0.02),
        'conv_ln_g': 1.0 + nrm(ks[12], (L, CONV_CH), 0.02),
        'conv_ln_b': nrm(ks[13], (L, CONV_CH), 0.02),
        'w_pw2': nrm(ks[14], (L, CONV_CH, D_MODEL), DN_BETA * CONV_CH ** -0.5),
        'b_pw2': nrm(ks[15], (L, D_MODEL), 0.02),
        'w_mem_k': nrm(ks[16], (L, D_MODEL, c_w), D_MODEL ** -0.5),
        'w_mem_v': nrm(ks[17], (L, D_MODEL, c_w), DN_BETA * D_MODEL ** -0.5),
        'w_o_c': nrm(ks[18], (L, c_w, D_MODEL), DN_BETA * c_w ** -0.5),
        'w_out': nrm(ks[19], (L, D_MODEL, D_MODEL), DN_BETA * D_MODEL ** -0.5),
        'b_out': nrm(ks[20], (L, D_MODEL), 0.02),
        'ln1_g': 1.0 + nrm(ks[21], (L, D_MODEL), 0.02),
        'ln1_b': nrm(ks[22], (L, D_MODEL), 0.02),
        'w_router': nrm(ks[23], (L, D_MODEL, N_EXPERTS), D_MODEL ** -0.5),
        'b_router': nrm(ks[24], (L, N_EXPERTS), 0.01),
        'w1': nrm(ks[25], (L, N_EXPERTS, D_MODEL, 2 * D_EXPERT), DN_BETA * D_MODEL ** -0.5),
        'b1': nrm(ks[26], (L, N_EXPERTS, 2 * D_EXPERT), 0.01),
        'w2': nrm(ks[27], (L, N_EXPERTS, D_EXPERT, D_MODEL), DN_BETA * D_EXPERT ** -0.5),
        'b2': nrm(ks[28], (L, N_EXPERTS, D_MODEL), 0.01),
        'ln2_g': 1.0 + nrm(ks[29], (L, D_MODEL), 0.02),
        'ln2_b': nrm(ks[30], (L, D_MODEL), 0.02),
    }


def reference(x, mem, ln0_g, ln0_b, w_in, b_in, kv_norm_g, w_uk, w_uv, w_o_a,
              w_dw, b_dw, conv_ln_g, conv_ln_b, w_pw2, b_pw2,
              w_mem_k, w_mem_v, w_o_c, w_out, b_out, ln1_g, ln1_b,
              w_router, b_router, w1, b1, w2, b2, ln2_g, ln2_b):
    bsz, seq, dm = x.shape
    h = _layer_norm(x, ln0_g, ln0_b)
    for l in range(DEPTH):
        proj = h @ w_in[l] + b_in[l]
        q_a, c_kv, q_idx, k_idx, w_idx, glu_in, q_c, gate_logits = _split_cols(proj)
        c_kv = _rms_norm(c_kv, kv_norm_g[l])
        y_a = _dsa_mla_attention(q_a.reshape(bsz, seq, A_HEADS, A_HEAD_DIM), c_kv,
                                 q_idx.reshape(bsz, seq, IDX_HEADS, IDX_DIM), k_idx, w_idx,
                                 w_uk[l], w_uv[l]) @ w_o_a[l]
        y_b = _conformer_conv(glu_in, w_dw[l], b_dw[l], conv_ln_g[l], conv_ln_b[l], w_pw2[l], b_pw2[l])
        y_c = _memory_attention(q_c, mem, w_mem_k[l], w_mem_v[l]) @ w_o_c[l]
        g = jax.nn.sigmoid(gate_logits).reshape(bsz, seq, N_BRANCH, dm)
        mixed = g[:, :, 0] * y_a + g[:, :, 1] * y_b + g[:, :, 2] * y_c
        h = _layer_norm(DN_ALPHA * h + (mixed @ w_out[l] + b_out[l]), ln1_g[l], ln1_b[l])
        h = _layer_norm(DN_ALPHA * h + _moe(h, w_router[l], b_router[l], w1[l], b1[l], w2[l], b2[l]),
                        ln2_g[l], ln2_b[l])
    return h
```

```cpp
#include <hip/hip_runtime.h>
#include <hip/hip_cooperative_groups.h>
#include <cstdio>
#include <cstdint>
namespace cg = cooperative_groups;
namespace pg8 {
#define PG8_LAS __attribute__((address_space(3)))
typedef unsigned short bf16_t;
typedef short bf16x8 __attribute__((ext_vector_type(8)));
typedef float f32x4 __attribute__((ext_vector_type(4)));
typedef unsigned u32x4 __attribute__((ext_vector_type(4)));
constexpr int BM = 256, BK = 64, HALF = 128, HTB = HALF * BK * 2  , STAGE_BYTES = 8 * HTB, NXCD = 8, WGM = 8;

__host__ __device__ __forceinline__ int lds_byte(int r, int c) { const int st = (r >> 4) * 2 + (c >> 5), rr = r & 15, cc = c & 31, ob = rr * 64 + cc * 2; return st * 1024 + (ob ^ (((ob >> 9) & 1) << 5)); }
__host__ __device__ __forceinline__ void stage_rc(int b, int& R, int& C) { const int st = b / 1024, sb = b % 1024, swz = sb ^ (((sb >> 9) & 1) << 5); R = (st >> 1) * 16 + swz / 64; C = (st & 1) * 32 + (swz % 64) / 2; }
__host__ __device__ __forceinline__ int perm32(int rho) { const int n = rho >> 4, i = rho & 15; return 8 * (i >> 2) + 4 * n + (i & 3); }

struct Unit { int pm, pn; };
struct Gemm { const bf16_t* A; const bf16_t* Bt; int M, N, K; };

struct StaticOrder {
    int nM, nN, nwg, G, c;
    __host__ __device__ void init(int M, int N, int G_, int c_) { nM = M / BM; nN = N / BM; nwg = nM * nN; G = G_; c = c_; }
    __host__ __device__ bool next(int i, Unit& u) const {
        const long L = (long)i * G + c; if (L >= nwg) return false;
        int wgid = (int)L; { const int q = nwg / NXCD, r = nwg % NXCD, xcd = wgid % NXCD, off = wgid / NXCD; wgid = (xcd < r ? xcd * (q + 1) : r * (q + 1) + (xcd - r) * q) + off; }
        const int nig = WGM * nN, gid = wgid / nig, fm = gid * WGM, gsz = (nM - fm) < WGM ? (nM - fm) : WGM;
        u.pm = fm + ((wgid % nig) % gsz); u.pn = (wgid % nig) / gsz; return true;
    }
    __device__ __forceinline__ void a_ready(const Unit&) const {}
    __device__ __forceinline__ void done(const Unit&) const {}
};

__device__ __forceinline__ unsigned cvt_pk_bf16(float lo, float hi) { unsigned r; asm volatile("v_cvt_pk_bf16_f32 %0, %1, %2" : "=v"(r) : "v"(lo), "v"(hi)); return r; }
typedef float f32x2 __attribute__((ext_vector_type(2)));
template <class Epi, class Sched, bool ALIGN_EPI = false, bool SP2 = false>
__device__ __forceinline__ void gemm_phase(PG8_LAS unsigned char* lds, const Gemm g, const Sched& S, const Epi& E) {
    const int tid = threadIdx.x, wid = __builtin_amdgcn_readfirstlane(tid >> 6), lane = tid & 63, wr = wid >> 2, wc = wid & 3, fr = lane & 15, fq = lane >> 4;
    const int K = g.K, nt = K / BK;
    unsigned voffA[2], voffB[2];
#pragma unroll
    for (int i = 0; i < 2; ++i) { int R, C; stage_rc(tid * 16 + i * 8192, R, C); const int Rb = Epi::PERM ? ((R & ~31) + perm32(R & 31)) : R;
        voffA[i] = (unsigned)(R * K + C) * 2u; voffB[i] = (unsigned)(Rb * K + C) * 2u; }
    const size_t kstep = (size_t)(BK * 2);
    const size_t hstep = (size_t)HALF * K * 2;
    const size_t tstep = 2 * hstep;
    const unsigned ldsw = (unsigned)wid * 1024u;
    const int aoff = lds_byte(wr * 64 + fr, fq * 8), boff = lds_byte(wc * 32 + fr, fq * 8);
#define PG8_SA(b, h) (((b) * 2 + (h)) * HTB)
#define PG8_SB(b, h) ((4 + (b) * 2 + (h)) * HTB)
#define PG8_STAGE(bufoff, gbase, voff) do { _Pragma("unroll") for (int _i = 0; _i < 2; ++_i) \
        __builtin_amdgcn_global_load_lds((const unsigned*)((const char*)(gbase) + (voff)[_i]), (PG8_LAS unsigned*)(lds + (bufoff) + ldsw + _i * 8192), 16, 0, 0); } while (0)
#define PG8_LDA(dst, b, h) do { _Pragma("unroll") for (int m = 0; m < 4; ++m) _Pragma("unroll") for (int k = 0; k < 2; ++k) dst[m][k] = *(const PG8_LAS bf16x8*)(lds + PG8_SA(b, h) + aoff + m * 2048 + k * 1024); } while (0)
#define PG8_LDB(dst, b, h) do { _Pragma("unroll") for (int n = 0; n < 2; ++n) _Pragma("unroll") for (int k = 0; k < 2; ++k) dst[n][k] = *(const PG8_LAS bf16x8*)(lds + PG8_SB(b, h) + boff + n * 2048 + k * 1024); } while (0)
#define PG8_MMA(ai, bj, At, Bt) do { __builtin_amdgcn_s_setprio(1); _Pragma("unroll") for (int m = 0; m < 4; ++m) _Pragma("unroll") for (int n = 0; n < 2; ++n) _Pragma("unroll") for (int k = 0; k < 2; ++k) \
        acc[ai][bj][m][n] = __builtin_amdgcn_mfma_f32_16x16x32_bf16(Bt[n][k], At[m][k], acc[ai][bj][m][n], 0, 0, 0); __builtin_amdgcn_s_setprio(0); } while (0)
#define PG8_WAIT_V(n) asm volatile("s_waitcnt vmcnt(" #n ")" ::: "memory")
#define PG8_WAIT_L(n) asm volatile("s_waitcnt lgkmcnt(" #n ")" ::: "memory")
#define PG8_BAR __builtin_amdgcn_s_barrier()
#define PG8_SCHED __builtin_amdgcn_sched_barrier(0)
    Unit cur, nxt; int ui = 0;
    if (!S.next(0, cur)) return;
    f32x4 acc[2][2][4][2];
#pragma unroll
    for (int a = 0; a < 2; ++a)
#pragma unroll
        for (int b = 0; b < 2; ++b)
#pragma unroll
            for (int m = 0; m < 4; ++m)
#pragma unroll
                for (int n = 0; n < 2; ++n) acc[a][b][m][n] = (f32x4){0.f, 0.f, 0.f, 0.f};
    bf16x8 At[4][2], B0[2][2], B1[2][2];
    const char* cA = (const char*)g.A + (size_t)cur.pm * tstep; const char* cB = (const char*)g.Bt + (size_t)cur.pn * tstep;
    S.a_ready(cur);
    if constexpr (SP2) {
        PG8_STAGE(PG8_SB(0, 0), cB, voffB); PG8_STAGE(PG8_SB(0, 1), cB + hstep, voffB); PG8_STAGE(PG8_SA(0, 0), cA, voffA); PG8_STAGE(PG8_SA(0, 1), cA + hstep, voffA);
        if (wr == 1) PG8_BAR;
        PG8_WAIT_V(2); PG8_BAR;
        PG8_STAGE(PG8_SB(1, 0), cB + kstep, voffB); PG8_STAGE(PG8_SA(1, 0), cA + kstep, voffA); PG8_STAGE(PG8_SB(1, 1), cB + hstep + kstep, voffB);
        PG8_WAIT_V(6); PG8_BAR;
    } else {
        PG8_STAGE(PG8_SB(0, 0), cB, voffB); PG8_STAGE(PG8_SA(0, 0), cA, voffA); PG8_STAGE(PG8_SB(0, 1), cB + hstep, voffB); PG8_STAGE(PG8_SA(0, 1), cA + hstep, voffA);
        if (wr == 1) PG8_BAR;
        PG8_WAIT_V(4); PG8_BAR;
        PG8_STAGE(PG8_SB(1, 0), cB + kstep, voffB); PG8_STAGE(PG8_SA(1, 0), cA + kstep, voffA); PG8_STAGE(PG8_SB(1, 1), cB + hstep + kstep, voffB);
        PG8_WAIT_V(6); PG8_BAR;
    }
    for (;;) {
        const bool has_next = S.next(ui + 1, nxt);
        const char* nA = has_next ? (const char*)g.A + (size_t)nxt.pm * tstep : cA; const char* nB = has_next ? (const char*)g.Bt + (size_t)nxt.pn * tstep : cB;
        for (int t = 0; t < nt; t += 2) {
            const bool last = (t == nt - 2);
            const char* a1 = cA + (size_t)(t + 1) * kstep;
            const char* a2 = last ? nA : cA + (size_t)(t + 2) * kstep; const char* b2 = last ? nB : cB + (size_t)(t + 2) * kstep;
            const char* a3 = a2 + kstep; const char* b3 = b2 + kstep;
            if (last && has_next) S.a_ready(nxt);
            if constexpr (SP2) {
            PG8_LDB(B0, 0, 0); PG8_LDB(B1, 0, 1); PG8_SCHED; PG8_LDA(At, 0, 0); PG8_STAGE(PG8_SA(1, 1), a1 + hstep, voffA);
            PG8_WAIT_V(8); PG8_WAIT_L(0); PG8_BAR; PG8_MMA(0, 0, At, B0); PG8_MMA(0, 1, At, B1); PG8_BAR; PG8_SCHED;
            PG8_LDA(At, 0, 1); PG8_STAGE(PG8_SB(0, 0), b2, voffB); PG8_STAGE(PG8_SB(0, 1), b2 + hstep, voffB); PG8_STAGE(PG8_SA(0, 0), a2, voffA);
            PG8_WAIT_V(8); PG8_WAIT_L(0); PG8_BAR; PG8_MMA(1, 0, At, B0); PG8_MMA(1, 1, At, B1); PG8_BAR; PG8_SCHED;
            PG8_LDB(B0, 1, 0); PG8_LDB(B1, 1, 1); PG8_SCHED; PG8_LDA(At, 1, 0); PG8_STAGE(PG8_SA(0, 1), a2 + hstep, voffA);
            PG8_WAIT_V(8); PG8_WAIT_L(0); PG8_BAR; PG8_MMA(0, 0, At, B0); PG8_MMA(0, 1, At, B1); PG8_BAR; PG8_SCHED;
            PG8_LDA(At, 1, 1); PG8_STAGE(PG8_SB(1, 0), b3, voffB); PG8_STAGE(PG8_SB(1, 1), b3 + hstep, voffB); PG8_STAGE(PG8_SA(1, 0), a3, voffA);
            PG8_WAIT_V(8); PG8_WAIT_L(0); PG8_BAR; PG8_MMA(1, 0, At, B0); PG8_MMA(1, 1, At, B1); PG8_BAR; PG8_SCHED;
            } else {
            PG8_LDB(B0, 0, 0); PG8_SCHED; PG8_LDA(At, 0, 0); PG8_STAGE(PG8_SA(1, 1), a1 + hstep, voffA);
            PG8_WAIT_L(8); PG8_BAR; PG8_WAIT_L(0); PG8_MMA(0, 0, At, B0); PG8_BAR; PG8_SCHED;
            PG8_LDB(B1, 0, 1); PG8_STAGE(PG8_SB(0, 0), b2, voffB);
            PG8_BAR; PG8_WAIT_L(0); PG8_MMA(0, 1, At, B1); PG8_BAR;
            PG8_LDA(At, 0, 1); PG8_STAGE(PG8_SA(0, 0), a2, voffA);
            PG8_BAR; PG8_WAIT_L(0); PG8_MMA(1, 0, At, B0); PG8_BAR; PG8_SCHED;
            PG8_STAGE(PG8_SB(0, 1), b2 + hstep, voffB);
            PG8_WAIT_V(6); PG8_BAR; PG8_MMA(1, 1, At, B1); PG8_BAR;
            PG8_LDB(B0, 1, 0); PG8_SCHED; PG8_LDA(At, 1, 0); PG8_STAGE(PG8_SA(0, 1), a2 + hstep, voffA);
            PG8_WAIT_L(8); PG8_BAR; PG8_WAIT_L(0); PG8_MMA(0, 0, At, B0); PG8_BAR; PG8_SCHED;
            PG8_LDB(B1, 1, 1); PG8_STAGE(PG8_SB(1, 0), b3, voffB);
            PG8_BAR; PG8_WAIT_L(0); PG8_MMA(0, 1, At, B1); PG8_BAR;
            PG8_LDA(At, 1, 1); PG8_STAGE(PG8_SA(1, 0), a3, voffA);
            PG8_BAR; PG8_WAIT_L(0); PG8_MMA(1, 0, At, B0); PG8_BAR; PG8_SCHED;
            PG8_STAGE(PG8_SB(1, 1), b3 + hstep, voffB);
            PG8_WAIT_V(6); PG8_BAR; PG8_MMA(1, 1, At, B1); PG8_BAR;
            }
        }
        if constexpr (ALIGN_EPI) { if (wr == 0) PG8_BAR; }
        if constexpr (!Epi::AFTER_DRAIN) { E(acc, cur, wr, wc, fr, fq); S.done(cur); }
        if (!has_next) break;
#pragma unroll
        for (int a = 0; a < 2; ++a)
#pragma unroll
            for (int b = 0; b < 2; ++b)
#pragma unroll
                for (int m = 0; m < 4; ++m)
#pragma unroll
                    for (int n = 0; n < 2; ++n) acc[a][b][m][n] = (f32x4){0.f, 0.f, 0.f, 0.f};
        cur = nxt; cA = nA; cB = nB; ++ui;
        if constexpr (ALIGN_EPI) { if (wr == 1) PG8_BAR; }
    }
    PG8_WAIT_V(0);
    if constexpr (!ALIGN_EPI) { if (wr == 0) PG8_BAR; }
    PG8_BAR;
    if constexpr (Epi::AFTER_DRAIN) { E.fused(acc, cur, wr, wc, fr, fq, lds, wid, lane); S.done(cur); }
#undef PG8_SA
#undef PG8_SB
#undef PG8_STAGE
#undef PG8_LDA
#undef PG8_LDB
#undef PG8_MMA
#undef PG8_WAIT_V
#undef PG8_WAIT_L
#undef PG8_BAR
#undef PG8_SCHED
}
}

#define GAS __attribute__((address_space(1)))
#define LAS __attribute__((address_space(3)))
typedef unsigned short bf16;
typedef unsigned v4u __attribute__((ext_vector_type(4)));
typedef unsigned v2u __attribute__((ext_vector_type(2)));
typedef float f32x4 __attribute__((ext_vector_type(4)));
typedef float f32x2 __attribute__((ext_vector_type(2)));
#define RLX_AGENT __ATOMIC_RELAXED, __HIP_MEMORY_SCOPE_AGENT
#define LDS_WAIT() asm volatile("s_waitcnt lgkmcnt(0)" ::: "memory")
#define VM_WAIT() asm volatile("s_waitcnt vmcnt(0)" ::: "memory")

constexpr int NWAVES = 8, NTHR = 512;
constexpr int BATCH = 2, T = 8192, D = 1024, M = BATCH * T;
constexpr int D_IN = 5544;
constexpr int NPROJ = 6144;
constexpr int NB1 = 7168;
constexpr int MA1 = M + 512;
constexpr int NEXP = 32, FF = 1024;
constexpr int MAXTILES = 288;
constexpr float LN_EPS = 1e-5f;
constexpr float DN_ALPHA = 1.189207115002721f;
constexpr float IDX_SCALE = 0.0625f;
constexpr float A_SCALE = 0.125f, C_SCALE = 0.08838834764831845f;
constexpr float SWIGLU_LIMIT = 7.0f, SWIGLU_ALPHA = 1.702f;

enum { I_X = 0, I_MEM, I_LN0G, I_LN0B, I_WIN, I_BIN, I_KVG, I_WUK, I_WUV, I_WOA, I_WDW, I_BDW, I_CLNG, I_CLNB, I_WPW2, I_BPW2,
       I_WMK, I_WMV, I_WOC, I_WOUT, I_BOUT, I_LN1G, I_LN1B, I_WR, I_BR, I_W1, I_B1, I_W2, I_B2, I_LN2G, I_LN2B, N_IN };

constexpr size_t MiB = 1u << 20;
constexpr size_t WS_CTL = 0, CTL_ZERO_BYTES = 1 * MiB;
constexpr size_t WS_WINT = 2 * MiB, WS_WOAT = 16 * MiB, WS_WPW2T = 18 * MiB, WS_WOCT = 19 * MiB, WS_WOUTT = 20 * MiB, WS_BIASP = 22 * MiB;
constexpr size_t WS_KMEM = 23 * MiB, WS_VMEM = 23 * MiB + 512 * 1024;
constexpr size_t WS_W1T = 24 * MiB, WS_W2T = 152 * MiB, WS_XN = 216 * MiB, WS_H1F = 249 * MiB, WS_H1B = 313 * MiB;
constexpr size_t WS_ROWTOK = 346 * MiB, WS_SLOTGATE = 348 * MiB;
constexpr size_t WS_QL = 352 * MiB, WS_CKV = 384 * MiB, WS_KIDX = 388 * MiB, WS_WIDX = 390 * MiB, WS_SSQ = 390 * MiB + 512 * 1024;
constexpr size_t WS_QIDX = 392 * MiB, WS_U = 408 * MiB, WS_QC = 424 * MiB, WS_G = 440 * MiB, WS_OLAT = 536 * MiB, WS_UB = 568 * MiB, WS_OC = 584 * MiB;
constexpr size_t WS_MIXF = 600 * MiB, WS_MIX = 664 * MiB;
constexpr size_t WS_XS = 352 * MiB, WS_HMID = 496 * MiB, WS_Y = 640 * MiB, WS_END = 768 * MiB;
constexpr int CW_CNT = 64;

constexpr int RING_OFF = 0, RING_BYTES = 131072;
constexpr int LDSCTL_OFF = 155648;
constexpr int LDS_BYTES = 163840;

__device__ __forceinline__ float bf2f(unsigned v) { return __uint_as_float(v << 16); }
__device__ __forceinline__ float bflo(unsigned v) { return __uint_as_float(v << 16); }
__device__ __forceinline__ float bfhi(unsigned v) { return __uint_as_float(v & 0xffff0000u); }
__device__ __forceinline__ unsigned f2bf(float f) { unsigned u = __float_as_uint(f); return (u + 0x7fffu + ((u >> 16) & 1u)) >> 16; }
__device__ __forceinline__ unsigned pk2(float lo, float hi) { return f2bf(lo) | (f2bf(hi) << 16); }
__device__ __forceinline__ float wave_sum(float v) {
#pragma unroll
    for (int o = 1; o < 64; o <<= 1) v += __shfl_xor(v, o);
    return v;
}
__device__ __forceinline__ float wave_max(float v) {
#pragma unroll
    for (int o = 1; o < 64; o <<= 1) v = fmaxf(v, __shfl_xor(v, o));
    return v;
}
__device__ __forceinline__ int wave_sum_i(int v) {
#pragma unroll
    for (int o = 1; o < 64; o <<= 1) v += __shfl_xor(v, o);
    return v;
}
__device__ __forceinline__ float sigmoidf_fast(float x) { return __builtin_amdgcn_rcpf(1.0f + __expf(-x)); }

struct Args { const float* in[N_IN]; float* out; unsigned char* ws; int ph_lo, ph_hi; };

struct Frame {
    LAS unsigned char* lds;
    int tid, lane, wave, G, bid, vcu;
};

__device__ __forceinline__ void transpose_item(const float* W, int K, int ldN, int col0, int ncols, bf16* WT, int dst_row0, LAS float* scr, int kb, int nb, int lane) {
    const int k0 = 64 * kb, nl = 32 * nb;
    const bool cv = (nl + (lane & 31)) < ncols;
#pragma unroll 8
    for (int i = 0; i < 32; ++i) { const int kk = 2 * i + (lane >> 5); scr[kk * 33 + (lane & 31)] = cv ? W[(size_t)(k0 + kk) * ldN + col0 + nl + (lane & 31)] : 0.f; }
    LDS_WAIT(); asm volatile("" ::: "memory");
    const int c = lane & 7;
#pragma unroll
    for (int j = 0; j < 4; ++j) { const int n = (lane >> 3) + 8 * j; const LAS float* s = scr + (8 * c) * 33 + n;
        v4u o; o.x = pk2(s[0 * 33], s[1 * 33]); o.y = pk2(s[2 * 33], s[3 * 33]); o.z = pk2(s[4 * 33], s[5 * 33]); o.w = pk2(s[6 * 33], s[7 * 33]);
        if (nl + n < ncols) *(v4u*)(WT + (size_t)(dst_row0 + nl + n) * K + k0 + 8 * c) = o; }
    LDS_WAIT(); asm volatile("" ::: "memory");
}
constexpr int seg_items(int K, int nc) { return (K / 64) * ((nc + 31) / 32); }

__device__ __forceinline__ void ln_row_to_bf16(const float* xrow, const float* g, const float* b, bf16* orow, int lane) {
    const f32x4* xr = (const f32x4*)xrow + lane;
    f32x4 v[4]; float s = 0.f;
#pragma unroll
    for (int j = 0; j < 4; ++j) { v[j] = xr[64 * j]; s += (v[j].x + v[j].y) + (v[j].z + v[j].w); }
    const float mean = wave_sum(s) * (1.f / D); float s2 = 0.f;
#pragma unroll
    for (int j = 0; j < 4; ++j) { v[j] = v[j] - mean; s2 += (v[j].x * v[j].x + v[j].y * v[j].y) + (v[j].z * v[j].z + v[j].w * v[j].w); }
    const float rstd = 1.f / sqrtf(wave_sum(s2) * (1.f / D) + LN_EPS);
    unsigned long long* o8 = (unsigned long long*)orow + lane;
#pragma unroll
    for (int j = 0; j < 4; ++j) { const f32x4 gg = ((const f32x4*)g)[64 * j + lane], bb = ((const f32x4*)b)[64 * j + lane];
        const f32x4 y = v[j] * rstd * gg + bb;
        o8[64 * j] = (unsigned long long)pk2(y.x, y.y) | ((unsigned long long)pk2(y.z, y.w) << 32); }
}

__device__ __forceinline__ int proj_src_col(int j) {
    if (j < 1024) return -1;
    if (j < 1280) { const int jj = j - 1024; if (jj < 128) return 512 + jj; if (jj < 160) return 896 + (jj - 128); if (jj < 168) return 928 + (jj - 160); return -1; }
    if (j < 1536) return 640 + (j - 1280);
    if (j < 2560) { const int jj = j - 1536, i = jj >> 8, w = jj & 255; return w < 128 ? 936 + 128 * i + w : 936 + 512 + 128 * i + (w - 128); }
    if (j < 3072) return 1960 + (j - 2560);
    return 2472 + (j - 3072);
}

__device__ __forceinline__ void p0_prologue(const Args& a, Frame& F) {
    unsigned char* ws = a.ws;
    LAS float* scr = (LAS float*)(F.lds + F.wave * 16384);
    const int lane = F.lane;
    const int gw = F.vcu * NWAVES + F.wave, NGW = F.G * NWAVES;
    bf16* WINT = (bf16*)(ws + WS_WINT);
    const float* w_in = a.in[I_WIN];
    for (int m = gw; m < M; m += NGW) ln_row_to_bf16(a.in[I_X] + (size_t)m * D, a.in[I_LN0G], a.in[I_LN0B], (bf16*)(ws + WS_XN) + (size_t)m * D, lane);
    for (int m = gw; m < 512; m += NGW) {
        const f32x4* xr = (const f32x4*)(a.in[I_MEM] + (size_t)m * D) + lane; unsigned long long* o8 = (unsigned long long*)((bf16*)(ws + WS_XN) + (size_t)(M + m) * D) + lane;
#pragma unroll
        for (int j = 0; j < 4; ++j) { const f32x4 y = xr[64 * j]; o8[64 * j] = (unsigned long long)pk2(y.x, y.y) | ((unsigned long long)pk2(y.z, y.w) << 32); }
    }
    for (int m = gw; m < 89; m += NGW) {
        v4u* o = (m < 88) ? (v4u*)(WINT + (size_t)(1024 + 168 + m) * D) : (v4u*)((bf16*)(ws + WS_H1B) + (size_t)M * D);
        o[lane] = (v4u){0, 0, 0, 0}; o[lane + 64] = (v4u){0, 0, 0, 0};
    }
    {
        float* BP = (float*)(ws + WS_BIASP); const float* b_in = a.in[I_BIN];
        for (int j = F.vcu * NTHR + F.tid; j < NB1; j += F.G * NTHR) {
            float v = 0.f;
            if (j < 1024) { const int h = j >> 7, r = j & 127; const float* uk = a.in[I_WUK] + (size_t)(h * 128 + r) * 64; float s = 0.f;
                for (int d = 0; d < 64; ++d) s += b_in[h * 64 + d] * uk[d];
                v = s * a.in[I_KVG][r] * A_SCALE; }
            else if (j < NPROJ) { const int sc = proj_src_col(j); v = sc >= 0 ? b_in[sc] : 0.f; }
            BP[j] = v;
        }
    }
    {
        for (int it = gw; it < 1024; it += NGW) {
            const int h = it >> 7, kblk = (it >> 3) & 15, rblk = it & 7;
            const int k = kblk * 64 + lane; float wv[64];
            const f32x4* src = (const f32x4*)(w_in + (size_t)k * D_IN + h * 64);
#pragma unroll
            for (int d4 = 0; d4 < 16; ++d4) { const f32x4 t4 = src[d4]; wv[4 * d4] = t4.x; wv[4 * d4 + 1] = t4.y; wv[4 * d4 + 2] = t4.z; wv[4 * d4 + 3] = t4.w; }
            for (int rr = 0; rr < 16; ++rr) { const int r = rblk * 16 + rr; const float* uk = a.in[I_WUK] + (size_t)(h * 128 + r) * 64; float s = 0.f;
#pragma unroll
                for (int d = 0; d < 64; ++d) s += wv[d] * uk[d];
                WINT[(size_t)(h * 128 + r) * D + k] = (bf16)f2bf(s * a.in[I_KVG][r] * A_SCALE); }
        }
        bf16* WOAT = (bf16*)(ws + WS_WOAT);
        for (int it = gw; it < 1024; it += NGW) {
            const int h = it >> 7, rblk = (it >> 6) & 1, nblk = it & 63;
            const int r = rblk * 64 + lane; float uv[64];
            const f32x4* src = (const f32x4*)(a.in[I_WUV] + (size_t)(h * 128 + r) * 64);
#pragma unroll
            for (int d4 = 0; d4 < 16; ++d4) { const f32x4 t4 = src[d4]; uv[4 * d4] = t4.x; uv[4 * d4 + 1] = t4.y; uv[4 * d4 + 2] = t4.z; uv[4 * d4 + 3] = t4.w; }
            const float gk = a.in[I_KVG][r];
            for (int nn = 0; nn < 16; ++nn) { const int n = nblk * 16 + nn; const float* oa = a.in[I_WOA] + (size_t)(h * 64) * D + n; float s = 0.f;
#pragma unroll
                for (int d = 0; d < 64; ++d) s += uv[d] * oa[(size_t)d * D];
                WOAT[(size_t)n * D + h * 128 + r] = (bf16)f2bf(s * gk); }
        }
    }
    {
        constexpr int N_SMALL = seg_items(1024, 128) + seg_items(1024, 32) + seg_items(1024, 8) + seg_items(1024, 256) + 8 * seg_items(1024, 128) + seg_items(1024, 512) + seg_items(1024, 3072)
                              + 2 * seg_items(1024, 512) + 2 * seg_items(512, 1024) + seg_items(1024, 1024);
        constexpr int N_W1 = NEXP * 16 * 64, N_W2 = NEXP * 16 * 32;
        constexpr int NITEMS = N_SMALL + N_W1 + N_W2;
#define SEG(Wp, K_, ld_, c0_, nc_, Dp, r0_) { const int nb_ = ((nc_) + 31) / 32, ns_ = ((K_) / 64) * nb_; if (r < ns_) { transpose_item(Wp, K_, ld_, c0_, nc_, Dp, r0_, scr, r / nb_, r % nb_, lane); continue; } r -= ns_; }
        for (int it = gw; it < NITEMS; it += NGW) {
            int r = it;
            SEG(w_in, 1024, D_IN, 512, 128, WINT, 1024);
            SEG(w_in, 1024, D_IN, 896, 32, WINT, 1024 + 128);
            SEG(w_in, 1024, D_IN, 928, 8, WINT, 1024 + 160);
            SEG(w_in, 1024, D_IN, 640, 256, WINT, 1280);
            SEG(w_in, 1024, D_IN, 936, 128, WINT, 1536);
            SEG(w_in, 1024, D_IN, 936 + 512, 128, WINT, 1536 + 128);
            SEG(w_in, 1024, D_IN, 936 + 128, 128, WINT, 1792);
            SEG(w_in, 1024, D_IN, 936 + 512 + 128, 128, WINT, 1792 + 128);
            SEG(w_in, 1024, D_IN, 936 + 256, 128, WINT, 2048);
            SEG(w_in, 1024, D_IN, 936 + 512 + 256, 128, WINT, 2048 + 128);
            SEG(w_in, 1024, D_IN, 936 + 384, 128, WINT, 2304);
            SEG(w_in, 1024, D_IN, 936 + 512 + 384, 128, WINT, 2304 + 128);
            SEG(w_in, 1024, D_IN, 1960, 512, WINT, 2560);
            SEG(w_in, 1024, D_IN, 2472, 3072, WINT, 3072);
            SEG(a.in[I_WMK], 1024, 512, 0, 512, WINT, 6144);
            SEG(a.in[I_WMV], 1024, 512, 0, 512, WINT, 6656);
            SEG(a.in[I_WPW2], 512, 1024, 0, 1024, (bf16*)(ws + WS_WPW2T), 0);
            SEG(a.in[I_WOC], 512, 1024, 0, 1024, (bf16*)(ws + WS_WOCT), 0);
            SEG(a.in[I_WOUT], 1024, 1024, 0, 1024, (bf16*)(ws + WS_WOUTT), 0);
            if (r < N_W1) {
                const int e = r >> 10, kb = (r >> 6) & 15, nb = r & 63, c = 32 * nb;
                const int dr = c < 1024 ? 256 * (c >> 7) + (c & 127) : 256 * ((c - 1024) >> 7) + 128 + ((c - 1024) & 127);
                transpose_item(a.in[I_W1] + (size_t)e * 1024 * 2048, 1024, 2048, c, 32, (bf16*)(ws + WS_W1T), e * 2048 + dr, scr, kb, 0, lane); continue; }
            r -= N_W1;
            { const int e = r >> 9, kb = (r >> 5) & 15, nb = r & 31;
              transpose_item(a.in[I_W2] + (size_t)e * 1024 * 1024, 1024, 1024, 32 * nb, 32, (bf16*)(ws + WS_W2T), e * 1024 + 32 * nb, scr, kb, 0, lane); }
        }
#undef SEG
    }
}

using pg8::Unit; using pg8::StaticOrder;
typedef pg8::f32x4 acc_t[2][2][4][2];

struct ProjOrder : StaticOrder {
    __device__ bool next(int i, Unit& u) const {
        const long L = (long)i * G + c;
        if (L < nwg) return StaticOrder::next(i, u);
        const int e = (int)(L - nwg); if (e >= 8) return false;
        u.pm = 64 + (e >> 2); u.pn = 24 + (e & 3); return true;
    }
};

__device__ __forceinline__ v4u pack8(const f32x4 v0, const f32x4 v1) { v4u w; w.x = pg8::cvt_pk_bf16(v0[0], v0[1]); w.y = pg8::cvt_pk_bf16(v0[2], v0[3]); w.z = pg8::cvt_pk_bf16(v1[0], v1[1]); w.w = pg8::cvt_pk_bf16(v1[2], v1[3]); return w; }
__device__ __forceinline__ f32x4 sig4(const f32x4 v) { f32x4 r; r.x = sigmoidf_fast(v.x); r.y = sigmoidf_fast(v.y); r.z = sigmoidf_fast(v.z); r.w = sigmoidf_fast(v.w); return r; }

struct EpiProj {
    static constexpr bool PERM = true, AFTER_DRAIN = false;
    const float* bias; unsigned char* ws;
    template <bool SIG> __device__ __forceinline__ void store_tile(const acc_t& acc, const f32x4 (&bv)[2][2], bf16* base, int ldc) const {
#pragma unroll
        for (int ai = 0; ai < 2; ++ai)
#pragma unroll
            for (int m = 0; m < 4; ++m) { bf16* rowp = base + (size_t)(ai * 128 + m * 16) * ldc;
#pragma unroll
                for (int bj = 0; bj < 2; ++bj) { f32x4 v0 = acc[ai][bj][m][0] + bv[bj][0], v1 = acc[ai][bj][m][1] + bv[bj][1];
                    if (SIG) { v0 = sig4(v0); v1 = sig4(v1); }
                    *(v4u*)(rowp + bj * 128) = pack8(v0, v1); } }
    }
    __device__ __forceinline__ void operator()(const acc_t& acc, const Unit& u, int wr, int wc, int fr, int fq) const {
        const int pn = u.pn, cl = wc * 32 + 8 * fq;
        const int row0 = u.pm * 256 + wr * 64 + fr;
        f32x4 bv[2][2];
#pragma unroll
        for (int bj = 0; bj < 2; ++bj)
#pragma unroll
            for (int n = 0; n < 2; ++n) bv[bj][n] = *(const f32x4*)(bias + pn * 256 + bj * 128 + cl + 4 * n);
        if (pn < 4) { store_tile<false>(acc, bv, (bf16*)(ws + WS_QL) + (size_t)row0 * 1024 + pn * 256 + cl, 1024); }
        else if (pn == 4) {
            bf16* CKV = (bf16*)(ws + WS_CKV); float* SSQ = (float*)(ws + WS_SSQ); float* KIDX = (float*)(ws + WS_KIDX); float* WIDX = (float*)(ws + WS_WIDX);
#pragma unroll
            for (int ai = 0; ai < 2; ++ai)
#pragma unroll
                for (int m = 0; m < 4; ++m) { const size_t row = (size_t)row0 + ai * 128 + m * 16;
                    const f32x4 v0 = acc[ai][0][m][0] + bv[0][0], v1 = acc[ai][0][m][1] + bv[0][1];
                    *(v4u*)(CKV + row * 128 + cl) = pack8(v0, v1);
                    float ss = (v0.x * v0.x + v0.y * v0.y) + (v0.z * v0.z + v0.w * v0.w) + (v1.x * v1.x + v1.y * v1.y) + (v1.z * v1.z + v1.w * v1.w);
                    ss += __shfl_xor(ss, 16); ss += __shfl_xor(ss, 32);
                    if (fq == 0) SSQ[row * 4 + wc] = ss;
                    const f32x4 k0 = acc[ai][1][m][0] + bv[1][0], k1 = acc[ai][1][m][1] + bv[1][1];
                    if (wc == 0) { *(f32x4*)(KIDX + row * 32 + 8 * fq) = k0; *(f32x4*)(KIDX + row * 32 + 8 * fq + 4) = k1; }
                    else if (wc == 1 && fq == 0) { *(f32x4*)(WIDX + row * 8) = k0; *(f32x4*)(WIDX + row * 8 + 4) = k1; } }
        }
        else if (pn == 5) {
            float* QIDX = (float*)(ws + WS_QIDX);
#pragma unroll
            for (int ai = 0; ai < 2; ++ai)
#pragma unroll
                for (int m = 0; m < 4; ++m) { float* rowp = QIDX + ((size_t)row0 + ai * 128 + m * 16) * 256 + cl;
#pragma unroll
                    for (int bj = 0; bj < 2; ++bj) { *(f32x4*)(rowp + bj * 128) = acc[ai][bj][m][0] + bv[bj][0]; *(f32x4*)(rowp + bj * 128 + 4) = acc[ai][bj][m][1] + bv[bj][1]; } }
        }
        else if (pn < 10) {
            bf16* U = (bf16*)(ws + WS_U) + (size_t)row0 * 512 + (pn - 6) * 128 + cl;
#pragma unroll
            for (int ai = 0; ai < 2; ++ai)
#pragma unroll
                for (int m = 0; m < 4; ++m) {
                    const f32x4 a0 = acc[ai][0][m][0] + bv[0][0], a1 = acc[ai][0][m][1] + bv[0][1];
                    const f32x4 g0 = sig4(acc[ai][1][m][0] + bv[1][0]), g1 = sig4(acc[ai][1][m][1] + bv[1][1]);
                    *(v4u*)(U + (size_t)(ai * 128 + m * 16) * 512) = pack8(a0 * g0, a1 * g1); }
        }
        else if (pn < 12) { store_tile<false>(acc, bv, (bf16*)(ws + WS_QC) + (size_t)row0 * 512 + (pn - 10) * 256 + cl, 512); }
        else if (pn < 24) { store_tile<true>(acc, bv, (bf16*)(ws + WS_G) + (size_t)row0 * 3072 + (pn - 12) * 256 + cl, 3072); }
        else {
            const int rm = row0 - M; bf16* base = (bf16*)(ws + (pn < 26 ? WS_KMEM : WS_VMEM)) + (size_t)rm * 512 + ((pn - 24) & 1) * 256 + cl;
            store_tile<false>(acc, bv, base, 512);
        }
    }
};

template <int SEG> struct EpiMix {
    static constexpr bool PERM = false, AFTER_DRAIN = false;
    const float* bias; unsigned char* ws;
    __device__ __forceinline__ void operator()(const acc_t& acc, const Unit& u, int wr, int wc, int fr, int fq) const {
        const int col0 = u.pn * 256 + wc * 32 + 4 * fq;
        const bf16* G = (const bf16*)(ws + WS_G); float* MIXF = (float*)(ws + WS_MIXF); bf16* MIX = (bf16*)(ws + WS_MIX);
#pragma unroll
        for (int ai = 0; ai < 2; ++ai)
#pragma unroll
            for (int m = 0; m < 4; ++m) { const size_t row = (size_t)u.pm * 256 + ai * 128 + wr * 64 + m * 16 + fr;
#pragma unroll
                for (int bj = 0; bj < 2; ++bj)
#pragma unroll
                    for (int n = 0; n < 2; ++n) { const int col = col0 + bj * 128 + n * 16;
                        const v2u gw = *(const v2u*)(G + row * 3072 + SEG * 1024 + col);
                        const f32x4 g = (f32x4){bflo(gw.x), bfhi(gw.x), bflo(gw.y), bfhi(gw.y)};
                        f32x4 v = acc[ai][bj][m][n];
                        if (SEG == 1) v = v + *(const f32x4*)(bias + col);
                        v = v * g;
                        if (SEG > 0) v = v + *(const f32x4*)(MIXF + row * 1024 + col);
                        if (SEG < 2) *(f32x4*)(MIXF + row * 1024 + col) = v;
                        else { v2u o; o.x = pg8::cvt_pk_bf16(v.x, v.y); o.y = pg8::cvt_pk_bf16(v.z, v.w); *(v2u*)(MIX + row * 1024 + col) = o; } } }
    }
};

struct EpiOut {
    static constexpr bool PERM = false, AFTER_DRAIN = false;
    const float* bias; unsigned char* ws;
    __device__ __forceinline__ void operator()(const acc_t& acc, const Unit& u, int wr, int wc, int fr, int fq) const {
        const int col0 = u.pn * 256 + wc * 32 + 4 * fq;
        const bf16* XN = (const bf16*)(ws + WS_XN); float* S1 = (float*)(ws + WS_H1F);
#pragma unroll
        for (int ai = 0; ai < 2; ++ai)
#pragma unroll
            for (int m = 0; m < 4; ++m) { const size_t row = (size_t)u.pm * 256 + ai * 128 + wr * 64 + m * 16 + fr;
#pragma unroll
                for (int bj = 0; bj < 2; ++bj)
#pragma unroll
                    for (int n = 0; n < 2; ++n) { const int col = col0 + bj * 128 + n * 16;
                        const v2u hw = *(const v2u*)(XN + row * 1024 + col);
                        const f32x4 h = (f32x4){bflo(hw.x), bfhi(hw.x), bflo(hw.y), bfhi(hw.y)};
                        *(f32x4*)(S1 + row * 1024 + col) = h * DN_ALPHA + acc[ai][bj][m][n] + *(const f32x4*)(bias + col); } }
    }
};

template <int NT> struct MoeOrder {
    const LAS int* tstart; int G, c;
    __device__ bool next(int i, Unit& u) const {
        const int L = i * G + c; if (L >= NT * tstart[NEXP]) return false;
        int e = 0; while (e < NEXP - 1 && L >= NT * tstart[e + 1]) ++e;
        const int te = tstart[e + 1] - tstart[e], idx = L - NT * tstart[e];
        u.pn = e * NT + idx / te; u.pm = tstart[e] + idx % te; return true;
    }
    __device__ __forceinline__ void a_ready(const Unit&) const {}
    __device__ __forceinline__ void done(const Unit&) const {}
};
struct EpiMoe1 {
    static constexpr bool PERM = true, AFTER_DRAIN = false;
    const float* b1; unsigned char* ws;
    __device__ __forceinline__ void operator()(const acc_t& acc, const Unit& u, int wr, int wc, int fr, int fq) const {
        const int e = u.pn >> 3, j = u.pn & 7, cl = wc * 32 + 8 * fq;
        const float* bg = b1 + (size_t)e * 2048 + j * 128 + cl; const float* bu = bg + 1024;
        const f32x4 bg0 = *(const f32x4*)bg, bg1 = *(const f32x4*)(bg + 4), bu0 = *(const f32x4*)bu, bu1 = *(const f32x4*)(bu + 4);
        bf16* H = (bf16*)(ws + WS_HMID) + ((size_t)u.pm * 256 + wr * 64 + fr) * 1024 + j * 128 + cl;
#pragma unroll
        for (int ai = 0; ai < 2; ++ai)
#pragma unroll
            for (int m = 0; m < 4; ++m) { f32x4 o[2];
#pragma unroll
                for (int n = 0; n < 2; ++n) { const f32x4 g = acc[ai][0][m][n] + (n ? bg1 : bg0), uu = acc[ai][1][m][n] + (n ? bu1 : bu0);
#pragma unroll
                    for (int q = 0; q < 4; ++q) { const float gc = fminf(g[q], SWIGLU_LIMIT), uc = fminf(fmaxf(uu[q], -SWIGLU_LIMIT), SWIGLU_LIMIT);
                        o[n][q] = (uc + 1.0f) * (gc * sigmoidf_fast(SWIGLU_ALPHA * gc)); } }
                *(v4u*)(H + (size_t)(ai * 128 + m * 16) * 1024) = pack8(o[0], o[1]); }
    }
};
struct EpiMoe2 {
    static constexpr bool PERM = true, AFTER_DRAIN = false;
    const float* b2; unsigned char* ws; const LAS int* tstart; const LAS int* cntl;
    __device__ __forceinline__ void operator()(const acc_t& acc, const Unit& u, int wr, int wc, int fr, int fq) const {
        const int e = u.pn >> 2, j = u.pn & 3, cl = wc * 32 + 8 * fq;
        const int p0 = (u.pm - tstart[e]) * 256 + wr * 64 + fr, ce = cntl[e];
        const int* ROWTOK = (const int*)(ws + WS_ROWTOK) + (size_t)e * M; const float* SG = (const float*)(ws + WS_SLOTGATE);
        bf16* Y = (bf16*)(ws + WS_Y);
        f32x4 bv[2][2];
#pragma unroll
        for (int bj = 0; bj < 2; ++bj)
#pragma unroll
            for (int n = 0; n < 2; ++n) bv[bj][n] = *(const f32x4*)(b2 + (size_t)e * 1024 + j * 256 + bj * 128 + cl + 4 * n);
#pragma unroll
        for (int ai = 0; ai < 2; ++ai)
#pragma unroll
            for (int m = 0; m < 4; ++m) { const int p = p0 + ai * 128 + m * 16;
                if (p < ce) { const int slot = ROWTOK[p]; const float gate = SG[slot]; bf16* yp = Y + (size_t)slot * 1024 + j * 256 + cl;
#pragma unroll
                    for (int bj = 0; bj < 2; ++bj) *(v4u*)(yp + bj * 128) = pack8((acc[ai][bj][m][0] + bv[bj][0]) * gate, (acc[ai][bj][m][1] + bv[bj][1]) * gate); } }
    }
};

__device__ __forceinline__ unsigned okey(float s) { const unsigned b = __float_as_uint(s); return (b & 0x80000000u) ? ~b : (b | 0x80000000u); }

__device__ __forceinline__ void dsa_phase(const Args& a, Frame& F) {
    unsigned char* ws = a.ws;
    LAS float* sc = (LAS float*)(F.lds);
    LAS float* qv = (LAS float*)(F.lds + 32768);
    LAS float* wv = qv + 256;
    LAS float* qlv = qv + 272;
    LAS int* sel = (LAS int*)(qv + 272 + 1024);
    LAS float* pb = (LAS float*)(sel + 256);
    LAS int* red = (LAS int*)(pb + 2048);
    const int tid = F.tid, lane = F.lane, wave = F.wave;
    const float* QIDX = (const float*)(ws + WS_QIDX); const float* KIDX = (const float*)(ws + WS_KIDX); const float* WIDX = (const float*)(ws + WS_WIDX);
    const bf16* QL = (const bf16*)(ws + WS_QL); const bf16* CKV = (const bf16*)(ws + WS_CKV); const float* SSQ = (const float*)(ws + WS_SSQ);
    bf16* OLAT = (bf16*)(ws + WS_OLAT);
    for (int q = F.bid; q < M; q += F.G) {
        const int b = q / T, t = q % T, N = 64 * ((t >> 6) + 1);
        if (tid < 256) qv[tid] = QIDX[(size_t)q * 256 + tid]; else if (tid < 264) wv[tid - 256] = WIDX[(size_t)q * 8 + (tid - 256)] * IDX_SCALE;
        for (int i = tid; i < 1024; i += NTHR) qlv[i] = bf2f(QL[(size_t)q * 1024 + i]);
        if (tid == 0) red[16] = 0;
        __syncthreads();
        int nsel;
        if (N > 256) {
            unsigned ok[16];
#pragma unroll
            for (int i = 0; i < 16; ++i) { const int key = tid + i * NTHR; ok[i] = 0u;
                if (key < N) { const f32x4* kp = (const f32x4*)(KIDX + (size_t)(b * T + key) * 32); f32x4 kv[8];
#pragma unroll
                    for (int j = 0; j < 8; ++j) kv[j] = kp[j];
                    float s = 0.f;
#pragma unroll
                    for (int h = 0; h < 8; ++h) { float d = 0.f;
#pragma unroll
                        for (int j = 0; j < 8; ++j) { const f32x4 qq = *(const LAS f32x4*)(qv + h * 32 + 4 * j); d += kv[j].x * qq.x + kv[j].y * qq.y + kv[j].z * qq.z + kv[j].w * qq.w; }
                        s += wv[h] * fmaxf(d, 0.f); }
                    s += 0.0f; sc[key] = s; ok[i] = okey(s); } }
            unsigned tau = 0u;
            for (int bit = 31; bit >= 0; --bit) {
                const unsigned cand = tau | (1u << bit); int cl = 0;
#pragma unroll
                for (int i = 0; i < 16; ++i) cl += (tid + i * NTHR < N && ok[i] >= cand) ? 1 : 0;
                cl = wave_sum_i(cl);
                LAS int* r = red + (bit & 1) * 8;
                if (lane == 0) r[wave] = cl;
                __syncthreads();
                const int tot = (r[0] + r[1]) + (r[2] + r[3]) + (r[4] + r[5]) + (r[6] + r[7]);
                if (tot >= 256) tau = cand;
            }
            int cgt = 0, ceq = 0;
#pragma unroll
            for (int i = 0; i < 16; ++i) { const bool v = tid + i * NTHR < N; cgt += (v && ok[i] > tau) ? 1 : 0; ceq += (v && ok[i] == tau) ? 1 : 0; }
            cgt = wave_sum_i(cgt); ceq = wave_sum_i(ceq);
            __syncthreads();
            if (lane == 0) { red[wave] = cgt; red[8 + wave] = ceq; }
            __syncthreads();
            int tgt = 0, teq = 0;
#pragma unroll
            for (int w = 0; w < 8; ++w) { tgt += red[w]; teq += red[8 + w]; }
            const int need = 256 - tgt;
            const bool all_ties = (teq == need);
#pragma unroll
            for (int i = 0; i < 16; ++i) { const int key = tid + i * NTHR;
                if (key < N && (ok[i] > tau || (all_ties && ok[i] == tau))) { const int pos = atomicAdd((int*)(red + 16), 1); sel[pos] = key; } }
            __syncthreads();
            if (!all_ties && tid == 0) { int pos = red[16], left = need;
                for (int key = 0; key < N && left > 0; ++key) if (okey(sc[key]) == tau) { sel[pos++] = key; --left; }
                red[16] = pos; }
            __syncthreads();
            nsel = red[16];
        } else {
            if (tid < N) sel[tid] = tid;
            nsel = N;
            __syncthreads();
        }
        {
            const int h = wave; const float slope = exp2f(-(float)(h + 1));
            float lg[4], sk[4]; float mx = -3.0e38f;
#pragma unroll
            for (int j = 0; j < 4; ++j) { const int idx = lane + 64 * j; lg[j] = -3.0e38f; sk[j] = 0.f;
                if (idx < nsel) { const int key = sel[idx]; const size_t row = (size_t)(b * T + key);
                    const v4u* cp = (const v4u*)(CKV + row * 128); float d = 0.f;
#pragma unroll
                    for (int c8 = 0; c8 < 16; ++c8) { const v4u w = cp[c8]; const LAS float* qq = qlv + h * 128 + c8 * 8;
                        const f32x4 q0 = *(const LAS f32x4*)qq, q1 = *(const LAS f32x4*)(qq + 4);
                        d += bflo(w.x) * q0.x + bfhi(w.x) * q0.y + bflo(w.y) * q0.z + bfhi(w.y) * q0.w + bflo(w.z) * q1.x + bfhi(w.z) * q1.y + bflo(w.w) * q1.z + bfhi(w.w) * q1.w; }
                    const f32x4 s4 = *(const f32x4*)(SSQ + row * 4);
                    sk[j] = 1.0f / sqrtf(((s4.x + s4.y) + (s4.z + s4.w)) * (1.0f / 128.0f) + LN_EPS);
                    const int dist = t > key ? t - key : key - t;
                    lg[j] = d * sk[j] - slope * (float)dist; }
                mx = fmaxf(mx, lg[j]); }
            mx = wave_max(mx);
            float ps = 0.f;
#pragma unroll
            for (int j = 0; j < 4; ++j) { lg[j] = (lane + 64 * j < nsel) ? __expf(lg[j] - mx) : 0.f; ps += lg[j]; }
            ps = wave_sum(ps); const float inv = 1.0f / ps;
#pragma unroll
            for (int j = 0; j < 4; ++j) pb[h * 256 + lane + 64 * j] = lg[j] * inv * sk[j];
            __syncthreads();
            float o0 = 0.f, o1 = 0.f;
#pragma unroll 8
            for (int k = 0; k < nsel; ++k) { const int key = sel[k]; const float pk = pb[h * 256 + k];
                const unsigned w = *(const unsigned*)(CKV + (size_t)(b * T + key) * 128 + 2 * lane);
                o0 += pk * bflo(w); o1 += pk * bfhi(w); }
            *(unsigned*)(OLAT + (size_t)q * 1024 + h * 128 + 2 * lane) = pk2(o0, o1);
        }
        __syncthreads();
    }
}

__device__ __forceinline__ void conv_phase(const Args& a, Frame& F) {
    unsigned char* ws = a.ws;
    LAS unsigned* Uin = (LAS unsigned*)(F.lds);
    LAS float* CT = (LAS float*)(F.lds + 65536);
    const bf16* U = (const bf16*)(ws + WS_U); bf16* UB = (bf16*)(ws + WS_UB);
    const int tid = F.tid, lane = F.lane, wave = F.wave;
    const int cp = tid & 255, th = tid >> 8;
    float w0[31], w1[31];
#pragma unroll
    for (int j = 0; j < 31; ++j) { const f32x2 w = *(const f32x2*)(a.in[I_WDW] + j * 512 + 2 * cp); w0[j] = w.x; w1[j] = w.y; }
    const f32x2 bd = *(const f32x2*)(a.in[I_BDW] + 2 * cp);
    for (int un = F.bid; un < M / 32; un += F.G) {
        const int b = un / (T / 32), t0 = (un % (T / 32)) * 32;
        for (int idx = tid; idx < 62 * 64; idx += NTHR) { const int rr = idx >> 6, ch = idx & 63, tt = t0 - 30 + rr;
            v4u v = (v4u){0, 0, 0, 0}; if (tt >= 0) v = *(const v4u*)(U + ((size_t)(b * T + tt)) * 512 + ch * 8);
            *(LAS v4u*)(Uin + rr * 256 + ch * 4) = v; }
        __syncthreads();
        for (int tt = 0; tt < 16; ++tt) { const int t = th * 16 + tt; float a0 = bd.x, a1 = bd.y;
#pragma unroll
            for (int j = 0; j < 31; ++j) { const unsigned v = Uin[(t + j) * 256 + cp]; a0 += w0[j] * bflo(v); a1 += w1[j] * bfhi(v); }
            *(LAS f32x2*)(CT + t * 512 + 2 * cp) = (f32x2){a0, a1}; }
        __syncthreads();
#pragma unroll
        for (int rr = 0; rr < 4; ++rr) { const int row = wave * 4 + rr; const LAS float* cr = CT + row * 512 + 8 * lane;
            f32x4 x0 = *(const LAS f32x4*)cr, x1 = *(const LAS f32x4*)(cr + 4);
            const float mean = wave_sum((x0.x + x0.y) + (x0.z + x0.w) + (x1.x + x1.y) + (x1.z + x1.w)) * (1.0f / 512.0f);
            x0 = x0 - mean; x1 = x1 - mean;
            const float var = wave_sum((x0.x * x0.x + x0.y * x0.y) + (x0.z * x0.z + x0.w * x0.w) + (x1.x * x1.x + x1.y * x1.y) + (x1.z * x1.z + x1.w * x1.w)) * (1.0f / 512.0f);
            const float rstd = 1.0f / sqrtf(var + LN_EPS);
            const f32x4 g0 = *(const f32x4*)(a.in[I_CLNG] + 8 * lane), g1 = *(const f32x4*)(a.in[I_CLNG] + 8 * lane + 4);
            const f32x4 b0 = *(const f32x4*)(a.in[I_CLNB] + 8 * lane), b1 = *(const f32x4*)(a.in[I_CLNB] + 8 * lane + 4);
            f32x4 y0 = x0 * rstd * g0 + b0, y1 = x1 * rstd * g1 + b1;
            y0 = y0 * sig4(y0); y1 = y1 * sig4(y1);
            *(v4u*)(UB + ((size_t)(b * T + t0 + row)) * 512 + 8 * lane) = pack8(y0, y1); }
        __syncthreads();
    }
}

__device__ __forceinline__ void memattn_phase(const Args& a, Frame& F) {
    unsigned char* ws = a.ws;
    constexpr int KP = 136;
    LAS bf16* Kl = (LAS bf16*)(F.lds);
    LAS bf16* Vl = (LAS bf16*)(F.lds + 256 * KP * 2);
    LAS float* qs = (LAS float*)(F.lds + 256 * KP * 2 + 65536);
    LAS float* ps = qs + 8 * 128;
    const bf16* KM = (const bf16*)(ws + WS_KMEM); const bf16* VM = (const bf16*)(ws + WS_VMEM); const bf16* QC = (const bf16*)(ws + WS_QC); bf16* OC = (bf16*)(ws + WS_OC);
    const int tid = F.tid, lane = F.lane, wave = F.wave;
    for (int un = F.bid; un < 256; un += F.G) {
        const int b = un >> 7, h = (un >> 5) & 3, t0 = (un & 31) * 256;
        for (int idx = tid; idx < 256 * 16; idx += NTHR) { const int mrow = idx >> 4, ch = idx & 15;
            *(LAS v4u*)(Kl + mrow * KP + ch * 8) = *(const v4u*)(KM + (size_t)(b * 256 + mrow) * 512 + h * 128 + ch * 8);
            *(LAS v4u*)(Vl + mrow * 128 + ch * 8) = *(const v4u*)(VM + (size_t)(b * 256 + mrow) * 512 + h * 128 + ch * 8); }
        __syncthreads();
        for (int tk = wave; tk < 256; tk += NWAVES) {
            const size_t row = (size_t)(b * T + t0 + tk);
            const unsigned qw = *(const unsigned*)(QC + row * 512 + h * 128 + 2 * lane);
            *(LAS f32x2*)(qs + wave * 128 + 2 * lane) = (f32x2){bflo(qw), bfhi(qw)};
            LDS_WAIT(); asm volatile("" ::: "memory");
            float lg[4]; float mx = -3.0e38f;
#pragma unroll
            for (int j = 0; j < 4; ++j) { const int mrow = lane + 64 * j; float d = 0.f;
#pragma unroll
                for (int c8 = 0; c8 < 16; ++c8) { const v4u w = *(const LAS v4u*)(Kl + mrow * KP + c8 * 8); const LAS float* qq = qs + wave * 128 + c8 * 8;
                    const f32x4 q0 = *(const LAS f32x4*)qq, q1 = *(const LAS f32x4*)(qq + 4);
                    d += bflo(w.x) * q0.x + bfhi(w.x) * q0.y + bflo(w.y) * q0.z + bfhi(w.y) * q0.w + bflo(w.z) * q1.x + bfhi(w.z) * q1.y + bflo(w.w) * q1.z + bfhi(w.w) * q1.w; }
                lg[j] = d * C_SCALE; mx = fmaxf(mx, lg[j]); }
            mx = wave_max(mx); float s = 0.f;
#pragma unroll
            for (int j = 0; j < 4; ++j) { lg[j] = __expf(lg[j] - mx); s += lg[j]; }
            s = wave_sum(s); const float inv = 1.0f / s;
#pragma unroll
            for (int j = 0; j < 4; ++j) ps[wave * 256 + lane + 64 * j] = lg[j] * inv;
            LDS_WAIT(); asm volatile("" ::: "memory");
            float o0 = 0.f, o1 = 0.f;
#pragma unroll 8
            for (int mrow = 0; mrow < 256; ++mrow) { const float p = ps[wave * 256 + mrow]; const unsigned w = *(const LAS unsigned*)(Vl + mrow * 128 + 2 * lane); o0 += p * bflo(w); o1 += p * bfhi(w); }
            *(unsigned*)(OC + row * 512 + h * 128 + 2 * lane) = pk2(o0, o1);
            LDS_WAIT(); asm volatile("" ::: "memory");
        }
        __syncthreads();
    }
}

__device__ __forceinline__ void router_phase(const Args& a, Frame& F) {
    unsigned char* ws = a.ws;
    LAS float* WRT = (LAS float*)(F.lds);
    LAS int* cntL = (LAS int*)(F.lds + 131072);
    LAS int* baseL = cntL + 32;
    LAS int* tokE = baseL + 32;
    LAS int* tokP = tokE + 256;
    const int tid = F.tid, lane = F.lane, wave = F.wave;
    float* H1F = (float*)(ws + WS_H1F); bf16* H1B = (bf16*)(ws + WS_H1B); float* SG = (float*)(ws + WS_SLOTGATE); int* ROWTOK = (int*)(ws + WS_ROWTOK);
    unsigned* cnt = (unsigned*)(ws + WS_CTL) + CW_CNT;
    for (int idx = tid; idx < 32768; idx += NTHR) { const int i = idx >> 5, e = idx & 31; WRT[e * 1024 + i] = a.in[I_WR][idx]; }
    for (int blk = F.bid; blk < M / 64; blk += F.G) {
        if (tid < 32) cntL[tid] = 0;
        __syncthreads();
        for (int tk = wave; tk < 64; tk += NWAVES) {
            const int tokl = tk, token = blk * 64 + tokl;
            float* srow = H1F + (size_t)token * D;
            f32x4 v[4]; float s = 0.f;
#pragma unroll
            for (int j = 0; j < 4; ++j) { v[j] = ((const f32x4*)srow)[64 * j + lane]; s += (v[j].x + v[j].y) + (v[j].z + v[j].w); }
            const float mean = wave_sum(s) * (1.f / D); float s2 = 0.f;
#pragma unroll
            for (int j = 0; j < 4; ++j) { v[j] = v[j] - mean; s2 += (v[j].x * v[j].x + v[j].y * v[j].y) + (v[j].z * v[j].z + v[j].w * v[j].w); }
            const float rstd = 1.f / sqrtf(wave_sum(s2) * (1.f / D) + LN_EPS);
#pragma unroll
            for (int j = 0; j < 4; ++j) { const f32x4 gg = ((const f32x4*)a.in[I_LN1G])[64 * j + lane], bb = ((const f32x4*)a.in[I_LN1B])[64 * j + lane];
                v[j] = v[j] * rstd * gg + bb;
                ((f32x4*)srow)[64 * j + lane] = v[j];
                ((unsigned long long*)(H1B + (size_t)token * D))[64 * j + lane] = (unsigned long long)pk2(v[j].x, v[j].y) | ((unsigned long long)pk2(v[j].z, v[j].w) << 32); }
            float lg[32];
#pragma unroll
            for (int e = 0; e < 32; ++e) { float p = 0.f;
#pragma unroll
                for (int j = 0; j < 4; ++j) { const f32x4 w = *(const LAS f32x4*)(WRT + e * 1024 + 256 * j + 4 * lane); p += (v[j].x * w.x + v[j].y * w.y) + (v[j].z * w.z + v[j].w * w.w); }
                lg[e] = wave_sum(p) + a.in[I_BR][e]; }
            int te[4]; float tv[4];
#pragma unroll
            for (int k = 0; k < 4; ++k) { float best = -3.0e38f; int bi = 0;
#pragma unroll
                for (int e = 0; e < 32; ++e) { const bool taken = (k > 0 && te[0] == e) || (k > 1 && te[1] == e) || (k > 2 && te[2] == e); if (!taken && lg[e] > best) { best = lg[e]; bi = e; } }
                te[k] = bi; tv[k] = best; }
            const float e0 = 1.0f, e1 = __expf(tv[1] - tv[0]), e2 = __expf(tv[2] - tv[0]), e3 = __expf(tv[3] - tv[0]); const float inv = 1.0f / (e0 + e1 + e2 + e3);
            if (lane < 4) { const int k = lane; const int e = k == 0 ? te[0] : k == 1 ? te[1] : k == 2 ? te[2] : te[3]; const float g = (k == 0 ? e0 : k == 1 ? e1 : k == 2 ? e2 : e3) * inv;
                const int lp = atomicAdd((int*)(cntL + e), 1);
                tokE[tokl * 4 + k] = e; tokP[tokl * 4 + k] = lp; SG[(size_t)token * 4 + k] = g; }
        }
        __syncthreads();
        if (tid < 32) baseL[tid] = (int)__hip_atomic_fetch_add(cnt + tid, (unsigned)cntL[tid], RLX_AGENT);
        __syncthreads();
        if (tid < 256) { const int e = tokE[tid]; ROWTOK[(size_t)e * M + baseL[e] + tokP[tid]] = (blk * 64) * 4 + tid; }
        __syncthreads();
    }
}

__device__ __forceinline__ void moe_table(const Args& a, Frame& F, LAS int* tstart, LAS int* cntl) {
    const unsigned* cnt = (const unsigned*)(a.ws + WS_CTL) + CW_CNT;
    if (F.tid < 32) cntl[F.tid] = (int)__hip_atomic_load(cnt + F.tid, RLX_AGENT);
    __syncthreads();
    if (F.tid == 0) { int s = 0; for (int e = 0; e < 32; ++e) { tstart[e] = s; s += (cntl[e] + 255) >> 8; } tstart[32] = s; }
    __syncthreads();
}

__device__ __forceinline__ void gather_phase(const Args& a, Frame& F, const LAS int* tstart, const LAS int* cntl) {
    unsigned char* ws = a.ws;
    const bf16* H1B = (const bf16*)(ws + WS_H1B); bf16* XS = (bf16*)(ws + WS_XS); const int* ROWTOK = (const int*)(ws + WS_ROWTOK);
    const int gw = F.vcu * NWAVES + F.wave, NGW = F.G * NWAVES; const int total = tstart[32] * 256;
    for (int R = gw; R < total; R += NGW) {
        const int tile = R >> 8; int e = 0; while (e < 31 && tile >= tstart[e + 1]) ++e;
        const int p = R - tstart[e] * 256; int tok = M;
        if (p < cntl[e]) tok = ROWTOK[(size_t)e * M + p] >> 2;
        const v4u* s = (const v4u*)(H1B + (size_t)tok * D); v4u* d = (v4u*)(XS + (size_t)R * D);
        d[F.lane] = s[F.lane]; d[F.lane + 64] = s[F.lane + 64];
    }
}

__device__ __forceinline__ void final_phase(const Args& a, Frame& F) {
    unsigned char* ws = a.ws;
    const float* H1F = (const float*)(ws + WS_H1F); const bf16* Y = (const bf16*)(ws + WS_Y);
    const int gw = F.vcu * NWAVES + F.wave, NGW = F.G * NWAVES, lane = F.lane;
    for (int token = gw; token < M; token += NGW) {
        f32x4 v[4]; float s = 0.f;
#pragma unroll
        for (int j = 0; j < 4; ++j) { v[j] = ((const f32x4*)(H1F + (size_t)token * D))[64 * j + lane] * DN_ALPHA;
#pragma unroll
            for (int k = 0; k < 4; ++k) { const v2u w = ((const v2u*)(Y + ((size_t)token * 4 + k) * D))[64 * j + lane]; v[j] = v[j] + (f32x4){bflo(w.x), bfhi(w.x), bflo(w.y), bfhi(w.y)}; }
            s += (v[j].x + v[j].y) + (v[j].z + v[j].w); }
        const float mean = wave_sum(s) * (1.f / D); float s2 = 0.f;
#pragma unroll
        for (int j = 0; j < 4; ++j) { v[j] = v[j] - mean; s2 += (v[j].x * v[j].x + v[j].y * v[j].y) + (v[j].z * v[j].z + v[j].w * v[j].w); }
        const float rstd = 1.f / sqrtf(wave_sum(s2) * (1.f / D) + LN_EPS);
#pragma unroll
        for (int j = 0; j < 4; ++j) { const f32x4 gg = ((const f32x4*)a.in[I_LN2G])[64 * j + lane], bb = ((const f32x4*)a.in[I_LN2B])[64 * j + lane];
            ((f32x4*)(a.out + (size_t)token * D))[64 * j + lane] = v[j] * rstd * gg + bb; }
    }
}

#ifndef MK_MULTI
#define MK_MULTI 0
#endif
constexpr int N_PHASES = 12;

__global__ void __launch_bounds__(NTHR, 2) fwd_kernel(Args a) {
    extern __shared__ __attribute__((aligned(16))) unsigned char lds_raw[];
    Frame F;
    F.lds = (LAS unsigned char*)lds_raw;
    F.tid = threadIdx.x; F.lane = F.tid & 63; F.wave = __builtin_amdgcn_readfirstlane(F.tid >> 6);
    F.G = gridDim.x; F.bid = blockIdx.x; F.vcu = (F.G % 8 == 0) ? (F.bid % 8) * (F.G / 8) + F.bid / 8 : F.bid;
    unsigned char* ws = a.ws;
    LAS int* tstart = (LAS int*)(F.lds + LDSCTL_OFF); LAS int* cntl = tstart + 40;
    const int lo = a.ph_lo, hi = a.ph_hi;
#define IN(k) (lo <= (k) && (k) < hi)
#if MK_MULTI
#define SEAM(k) do { } while (0)
#else
#define SEAM(k) do { if (IN(k) && IN((k) + 1)) { cg::this_grid().sync(); } } while (0)
#endif
    if (IN(0)) { p0_prologue(a, F); } SEAM(0);
    if (IN(1)) {
        pg8::Gemm g{(const bf16*)(ws + WS_XN), (const bf16*)(ws + WS_WINT), MA1, NB1, D};
        ProjOrder S; S.init(M, NPROJ, F.G, F.bid);
        EpiProj E{(const float*)(ws + WS_BIASP), ws};
        pg8::gemm_phase<EpiProj, ProjOrder, true, true>(F.lds + RING_OFF, g, S, E);
    } SEAM(1);
    if (IN(2)) { dsa_phase(a, F); __syncthreads(); conv_phase(a, F); __syncthreads(); memattn_phase(a, F); } SEAM(2);
    if (IN(3)) {
        { pg8::Gemm g{(const bf16*)(ws + WS_OLAT), (const bf16*)(ws + WS_WOAT), M, D, D}; StaticOrder S; S.init(M, D, F.G, F.bid); EpiMix<0> E{nullptr, ws};
          pg8::gemm_phase<EpiMix<0>, StaticOrder, false, true>(F.lds + RING_OFF, g, S, E); }
        { pg8::Gemm g{(const bf16*)(ws + WS_UB), (const bf16*)(ws + WS_WPW2T), M, D, 512}; StaticOrder S; S.init(M, D, F.G, F.bid); EpiMix<1> E{a.in[I_BPW2], ws};
          pg8::gemm_phase<EpiMix<1>, StaticOrder, false, true>(F.lds + RING_OFF, g, S, E); }
        { pg8::Gemm g{(const bf16*)(ws + WS_OC), (const bf16*)(ws + WS_WOCT), M, D, 512}; StaticOrder S; S.init(M, D, F.G, F.bid); EpiMix<2> E{nullptr, ws};
          pg8::gemm_phase<EpiMix<2>, StaticOrder, false, true>(F.lds + RING_OFF, g, S, E); }
    } SEAM(3);
    if (IN(4)) {
        pg8::Gemm g{(const bf16*)(ws + WS_MIX), (const bf16*)(ws + WS_WOUTT), M, D, D}; StaticOrder S; S.init(M, D, F.G, F.bid); EpiOut E{a.in[I_BOUT], ws};
        pg8::gemm_phase<EpiOut, StaticOrder, false, true>(F.lds + RING_OFF, g, S, E);
    } SEAM(4);
    if (IN(5)) { router_phase(a, F); } SEAM(5);
    if (IN(6)) { moe_table(a, F, tstart, cntl); gather_phase(a, F, tstart, cntl); } SEAM(6);
    if (IN(7)) {
        moe_table(a, F, tstart, cntl);
        pg8::Gemm g{(const bf16*)(ws + WS_XS), (const bf16*)(ws + WS_W1T), MAXTILES * 256, NEXP * 2048, D};
        MoeOrder<8> S{tstart, F.G, F.vcu}; EpiMoe1 E{a.in[I_B1], ws};
        pg8::gemm_phase<EpiMoe1, MoeOrder<8>, true, true>(F.lds + RING_OFF, g, S, E);
    } SEAM(7);
    if (IN(8)) {
        moe_table(a, F, tstart, cntl);
        pg8::Gemm g{(const bf16*)(ws + WS_HMID), (const bf16*)(ws + WS_W2T), MAXTILES * 256, NEXP * 1024, FF};
        MoeOrder<4> S{tstart, F.G, F.vcu}; EpiMoe2 E{a.in[I_B2], ws, tstart, cntl};
        pg8::gemm_phase<EpiMoe2, MoeOrder<4>, true, true>(F.lds + RING_OFF, g, S, E);
    } SEAM(8);
    if (IN(9)) { final_phase(a, F); }
#undef IN
#undef SEAM
}

extern "C" void kernel_launch(void* const* d_in, const int* in_sizes, int n_in, void* d_out, int out_size, void* d_ws, size_t ws_size, hipStream_t stream) {
    static int grid = 0;
    if (grid == 0) {
        if (n_in != N_IN || out_size != M * D || ws_size < WS_END) { fprintf(stderr, "kernel_launch: unexpected shapes (n_in %d, out %d, ws %zu); nothing launched\n", n_in, out_size, ws_size); grid = -1; return; }
        int dev = 0, cus = 0, per_cu = 0;
        if (hipGetDevice(&dev) != hipSuccess || hipDeviceGetAttribute(&cus, hipDeviceAttributeMultiprocessorCount, dev) != hipSuccess) { grid = -1; return; }
        if (hipFuncSetAttribute((const void*)fwd_kernel, hipFuncAttributeMaxDynamicSharedMemorySize, LDS_BYTES) != hipSuccess) { fprintf(stderr, "kernel_launch: hipFuncSetAttribute failed\n"); grid = -1; return; }
        if (hipOccupancyMaxActiveBlocksPerMultiprocessor(&per_cu, (const void*)fwd_kernel, NTHR, LDS_BYTES) != hipSuccess || per_cu < 1) { fprintf(stderr, "kernel_launch: occupancy query failed (%d)\n", per_cu); (void)hipGetLastError(); grid = -1; return; }
        grid = cus;
    }
    if (grid < 0) return;
    (void)hipMemsetAsync((char*)d_ws + WS_CTL, 0, CTL_ZERO_BYTES, stream);
    Args a{};
    for (int i = 0; i < N_IN; ++i) a.in[i] = (const float*)d_in[i];
    a.out = (float*)d_out; a.ws = (unsigned char*)d_ws;
#if MK_MULTI
    for (int p = 0; p < 10; ++p) { a.ph_lo = p; a.ph_hi = p + 1; hipLaunchKernelGGL(fwd_kernel, dim3(grid), dim3(NTHR), LDS_BYTES, stream, a); }
#else
    a.ph_lo = 0; a.ph_hi = 10;
    void* args[] = {&a};
    hipError_t e = hipLaunchCooperativeKernel((const void*)fwd_kernel, dim3(grid), dim3(NTHR), args, LDS_BYTES, stream);
    if (e != hipSuccess) fprintf(stderr, "kernel_launch: cooperative launch failed: %s (grid %d)\n", hipGetErrorString(e), grid);
#endif
}
```

```cpp
#include <hip/hip_runtime.h>
#include <hip/hip_cooperative_groups.h>
#include <cstdio>
#include <cstdint>
namespace cg = cooperative_groups;
namespace pg8 {
#define PG8_LAS __attribute__((address_space(3)))
typedef unsigned short bf16_t;
typedef short bf16x8 __attribute__((ext_vector_type(8)));
typedef float f32x4 __attribute__((ext_vector_type(4)));
typedef unsigned u32x4 __attribute__((ext_vector_type(4)));
constexpr int BM = 256, BK = 64, HALF = 128, HTB = HALF * BK * 2  , STAGE_BYTES = 8 * HTB, NXCD = 8, WGM = 8;

__host__ __device__ __forceinline__ int lds_byte(int r, int c) { const int st = (r >> 4) * 2 + (c >> 5), rr = r & 15, cc = c & 31, ob = rr * 64 + cc * 2; return st * 1024 + (ob ^ (((ob >> 9) & 1) << 5)); }
__host__ __device__ __forceinline__ void stage_rc(int b, int& R, int& C) { const int st = b / 1024, sb = b % 1024, swz = sb ^ (((sb >> 9) & 1) << 5); R = (st >> 1) * 16 + swz / 64; C = (st & 1) * 32 + (swz % 64) / 2; }
__host__ __device__ __forceinline__ int perm32(int rho) { const int n = rho >> 4, i = rho & 15; return 8 * (i >> 2) + 4 * n + (i & 3); }

struct Unit { int pm, pn; };
struct Gemm { const bf16_t* A; const bf16_t* Bt; int M, N, K; };

struct StaticOrder {
    int nM, nN, nwg, G, c;
    __host__ __device__ void init(int M, int N, int G_, int c_) { nM = M / BM; nN = N / BM; nwg = nM * nN; G = G_; c = c_; }
    __host__ __device__ bool next(int i, Unit& u) const {
        const long L = (long)i * G + c; if (L >= nwg) return false;
        int wgid = (int)L; { const int q = nwg / NXCD, r = nwg % NXCD, xcd = wgid % NXCD, off = wgid / NXCD; wgid = (xcd < r ? xcd * (q + 1) : r * (q + 1) + (xcd - r) * q) + off; }
        const int nig = WGM * nN, gid = wgid / nig, fm = gid * WGM, gsz = (nM - fm) < WGM ? (nM - fm) : WGM;
        u.pm = fm + ((wgid % nig) % gsz); u.pn = (wgid % nig) / gsz; return true;
    }
    __device__ __forceinline__ void a_ready(const Unit&) const {}
    __device__ __forceinline__ void done(const Unit&) const {}
};

__device__ __forceinline__ unsigned cvt_pk_bf16(float lo, float hi) { unsigned r; asm volatile("v_cvt_pk_bf16_f32 %0, %1, %2" : "=v"(r) : "v"(lo), "v"(hi)); return r; }
typedef float f32x2 __attribute__((ext_vector_type(2)));
template <class Epi, class Sched, bool ALIGN_EPI = false, bool SP2 = false>
__device__ __forceinline__ void gemm_phase(PG8_LAS unsigned char* lds, const Gemm g, const Sched& S, const Epi& E) {
    const int tid = threadIdx.x, wid = __builtin_amdgcn_readfirstlane(tid >> 6), lane = tid & 63, wr = wid >> 2, wc = wid & 3, fr = lane & 15, fq = lane >> 4;
    const int K = g.K, nt = K / BK;
    unsigned voffA[2], voffB[2];
#pragma unroll
    for (int i = 0; i < 2; ++i) { int R, C; stage_rc(tid * 16 + i * 8192, R, C); const int Rb = Epi::PERM ? ((R & ~31) + perm32(R & 31)) : R;
        voffA[i] = (unsigned)(R * K + C) * 2u; voffB[i] = (unsigned)(Rb * K + C) * 2u; }
    const size_t kstep = (size_t)(BK * 2);
    const size_t hstep = (size_t)HALF * K * 2;
    const size_t tstep = 2 * hstep;
    const unsigned ldsw = (unsigned)wid * 1024u;
    const int aoff = lds_byte(wr * 64 + fr, fq * 8), boff = lds_byte(wc * 32 + fr, fq * 8);
#define PG8_SA(b, h) (((b) * 2 + (h)) * HTB)
#define PG8_SB(b, h) ((4 + (b) * 2 + (h)) * HTB)
#define PG8_STAGE(bufoff, gbase, voff) do { _Pragma("unroll") for (int _i = 0; _i < 2; ++_i) \
        __builtin_amdgcn_global_load_lds((const unsigned*)((const char*)(gbase) + (voff)[_i]), (PG8_LAS unsigned*)(lds + (bufoff) + ldsw + _i * 8192), 16, 0, 0); } while (0)
#define PG8_LDA(dst, b, h) do { _Pragma("unroll") for (int m = 0; m < 4; ++m) _Pragma("unroll") for (int k = 0; k < 2; ++k) dst[m][k] = *(const PG8_LAS bf16x8*)(lds + PG8_SA(b, h) + aoff + m * 2048 + k * 1024); } while (0)
#define PG8_LDB(dst, b, h) do { _Pragma("unroll") for (int n = 0; n < 2; ++n) _Pragma("unroll") for (int k = 0; k < 2; ++k) dst[n][k] = *(const PG8_LAS bf16x8*)(lds + PG8_SB(b, h) + boff + n * 2048 + k * 1024); } while (0)
#define PG8_MMA(ai, bj, At, Bt) do { __builtin_amdgcn_s_setprio(1); _Pragma("unroll") for (int m = 0; m < 4; ++m) _Pragma("unroll") for (int n = 0; n < 2; ++n) _Pragma("unroll") for (int k = 0; k < 2; ++k) \
        acc[ai][bj][m][n] = __builtin_amdgcn_mfma_f32_16x16x32_bf16(Bt[n][k], At[m][k], acc[ai][bj][m][n], 0, 0, 0); __builtin_amdgcn_s_setprio(0); } while (0)
#define PG8_WAIT_V(n) asm volatile("s_waitcnt vmcnt(" #n ")" ::: "memory")
#define PG8_WAIT_L(n) asm volatile("s_waitcnt lgkmcnt(" #n ")" ::: "memory")
#define PG8_BAR __builtin_amdgcn_s_barrier()
#define PG8_SCHED __builtin_amdgcn_sched_barrier(0)
    Unit cur, nxt; int ui = 0;
    if (!S.next(0, cur)) return;
    f32x4 acc[2][2][4][2];
#pragma unroll
    for (int a = 0; a < 2; ++a)
#pragma unroll
        for (int b = 0; b < 2; ++b)
#pragma unroll
            for (int m = 0; m < 4; ++m)
#pragma unroll
                for (int n = 0; n < 2; ++n) acc[a][b][m][n] = (f32x4){0.f, 0.f, 0.f, 0.f};
    bf16x8 At[4][2], B0[2][2], B1[2][2];
    const char* cA = (const char*)g.A + (size_t)cur.pm * tstep; const char* cB = (const char*)g.Bt + (size_t)cur.pn * tstep;
    S.a_ready(cur);
    if constexpr (SP2) {
        PG8_STAGE(PG8_SB(0, 0), cB, voffB); PG8_STAGE(PG8_SB(0, 1), cB + hstep, voffB); PG8_STAGE(PG8_SA(0, 0), cA, voffA); PG8_STAGE(PG8_SA(0, 1), cA + hstep, voffA);
        if (wr == 1) PG8_BAR;
        PG8_WAIT_V(2); PG8_BAR;
        PG8_STAGE(PG8_SB(1, 0), cB + kstep, voffB); PG8_STAGE(PG8_SA(1, 0), cA + kstep, voffA); PG8_STAGE(PG8_SB(1, 1), cB + hstep + kstep, voffB);
        PG8_WAIT_V(6); PG8_BAR;
    } else {
        PG8_STAGE(PG8_SB(0, 0), cB, voffB); PG8_STAGE(PG8_SA(0, 0), cA, voffA); PG8_STAGE(PG8_SB(0, 1), cB + hstep, voffB); PG8_STAGE(PG8_SA(0, 1), cA + hstep, voffA);
        if (wr == 1) PG8_BAR;
        PG8_WAIT_V(4); PG8_BAR;
        PG8_STAGE(PG8_SB(1, 0), cB + kstep, voffB); PG8_STAGE(PG8_SA(1, 0), cA + kstep, voffA); PG8_STAGE(PG8_SB(1, 1), cB + hstep + kstep, voffB);
        PG8_WAIT_V(6); PG8_BAR;
    }
    for (;;) {
        const bool has_next = S.next(ui + 1, nxt);
        const char* nA = has_next ? (const char*)g.A + (size_t)nxt.pm * tstep : cA; const char* nB = has_next ? (const char*)g.Bt + (size_t)nxt.pn * tstep : cB;
        for (int t = 0; t < nt; t += 2) {
            const bool last = (t == nt - 2);
            const char* a1 = cA + (size_t)(t + 1) * kstep;
            const char* a2 = last ? nA : cA + (size_t)(t + 2) * kstep; const char* b2 = last ? nB : cB + (size_t)(t + 2) * kstep;
            const char* a3 = a2 + kstep; const char* b3 = b2 + kstep;
            if (last && has_next) S.a_ready(nxt);
            if constexpr (SP2) {
            PG8_LDB(B0, 0, 0); PG8_LDB(B1, 0, 1); PG8_SCHED; PG8_LDA(At, 0, 0); PG8_STAGE(PG8_SA(1, 1), a1 + hstep, voffA);
            PG8_WAIT_V(8); PG8_WAIT_L(0); PG8_BAR; PG8_MMA(0, 0, At, B0); PG8_MMA(0, 1, At, B1); PG8_BAR; PG8_SCHED;
            PG8_LDA(At, 0, 1); PG8_STAGE(PG8_SB(0, 0), b2, voffB); PG8_STAGE(PG8_SB(0, 1), b2 + hstep, voffB); PG8_STAGE(PG8_SA(0, 0), a2, voffA);
            PG8_WAIT_V(8); PG8_WAIT_L(0); PG8_BAR; PG8_MMA(1, 0, At, B0); PG8_MMA(1, 1, At, B1); PG8_BAR; PG8_SCHED;
            PG8_LDB(B0, 1, 0); PG8_LDB(B1, 1, 1); PG8_SCHED; PG8_LDA(At, 1, 0); PG8_STAGE(PG8_SA(0, 1), a2 + hstep, voffA);
            PG8_WAIT_V(8); PG8_WAIT_L(0); PG8_BAR; PG8_MMA(0, 0, At, B0); PG8_MMA(0, 1, At, B1); PG8_BAR; PG8_SCHED;
            PG8_LDA(At, 1, 1); PG8_STAGE(PG8_SB(1, 0), b3, voffB); PG8_STAGE(PG8_SB(1, 1), b3 + hstep, voffB); PG8_STAGE(PG8_SA(1, 0), a3, voffA);
            PG8_WAIT_V(8); PG8_WAIT_L(0); PG8_BAR; PG8_MMA(1, 0, At, B0); PG8_MMA(1, 1, At, B1); PG8_BAR; PG8_SCHED;
            } else {
            PG8_LDB(B0, 0, 0); PG8_SCHED; PG8_LDA(At, 0, 0); PG8_STAGE(PG8_SA(1, 1), a1 + hstep, voffA);
            PG8_WAIT_L(8); PG8_BAR; PG8_WAIT_L(0); PG8_MMA(0, 0, At, B0); PG8_BAR; PG8_SCHED;
            PG8_LDB(B1, 0, 1); PG8_STAGE(PG8_SB(0, 0), b2, voffB);
            PG8_BAR; PG8_WAIT_L(0); PG8_MMA(0, 1, At, B1); PG8_BAR;
            PG8_LDA(At, 0, 1); PG8_STAGE(PG8_SA(0, 0), a2, voffA);
            PG8_BAR; PG8_WAIT_L(0); PG8_MMA(1, 0, At, B0); PG8_BAR; PG8_SCHED;
            PG8_STAGE(PG8_SB(0, 1), b2 + hstep, voffB);
            PG8_WAIT_V(6); PG8_BAR; PG8_MMA(1, 1, At, B1); PG8_BAR;
            PG8_LDB(B0, 1, 0); PG8_SCHED; PG8_LDA(At, 1, 0); PG8_STAGE(PG8_SA(0, 1), a2 + hstep, voffA);
            PG8_WAIT_L(8); PG8_BAR; PG8_WAIT_L(0); PG8_MMA(0, 0, At, B0); PG8_BAR; PG8_SCHED;
            PG8_LDB(B1, 1, 1); PG8_STAGE(PG8_SB(1, 0), b3, voffB);
            PG8_BAR; PG8_WAIT_L(0); PG8_MMA(0, 1, At, B1); PG8_BAR;
            PG8_LDA(At, 1, 1); PG8_STAGE(PG8_SA(1, 0), a3, voffA);
            PG8_BAR; PG8_WAIT_L(0); PG8_MMA(1, 0, At, B0); PG8_BAR; PG8_SCHED;
            PG8_STAGE(PG8_SB(1, 1), b3 + hstep, voffB);
            PG8_WAIT_V(6); PG8_BAR; PG8_MMA(1, 1, At, B1); PG8_BAR;
            }
        }
        if constexpr (ALIGN_EPI) { if (wr == 0) PG8_BAR; }
        if constexpr (!Epi::AFTER_DRAIN) { E(acc, cur, wr, wc, fr, fq); S.done(cur); }
        if (!has_next) break;
#pragma unroll
        for (int a = 0; a < 2; ++a)
#pragma unroll
            for (int b = 0; b < 2; ++b)
#pragma unroll
                for (int m = 0; m < 4; ++m)
#pragma unroll
                    for (int n = 0; n < 2; ++n) acc[a][b][m][n] = (f32x4){0.f, 0.f, 0.f, 0.f};
        cur = nxt; cA = nA; cB = nB; ++ui;
        if constexpr (ALIGN_EPI) { if (wr == 1) PG8_BAR; }
    }
    PG8_WAIT_V(0);
    if constexpr (!ALIGN_EPI) { if (wr == 0) PG8_BAR; }
    PG8_BAR;
    if constexpr (Epi::AFTER_DRAIN) { E.fused(acc, cur, wr, wc, fr, fq, lds, wid, lane); S.done(cur); }
#undef PG8_SA
#undef PG8_SB
#undef PG8_STAGE
#undef PG8_LDA
#undef PG8_LDB
#undef PG8_MMA
#undef PG8_WAIT_V
#undef PG8_WAIT_L
#undef PG8_BAR
#undef PG8_SCHED
}
}

#define GAS __attribute__((address_space(1)))
#define LAS __attribute__((address_space(3)))
typedef unsigned short bf16;
typedef unsigned v4u __attribute__((ext_vector_type(4)));
typedef unsigned v2u __attribute__((ext_vector_type(2)));
typedef float f32x4 __attribute__((ext_vector_type(4)));
typedef float f32x2 __attribute__((ext_vector_type(2)));
#define RLX_AGENT __ATOMIC_RELAXED, __HIP_MEMORY_SCOPE_AGENT
#define LDS_WAIT() asm volatile("s_waitcnt lgkmcnt(0)" ::: "memory")
#define VM_WAIT() asm volatile("s_waitcnt vmcnt(0)" ::: "memory")

constexpr int NWAVES = 8, NTHR = 512;
constexpr int BATCH = 2, T = 8192, D = 1024, M = BATCH * T;
constexpr int D_IN = 5544;
constexpr int NPROJ = 6144;
constexpr int NB1 = 7168;
constexpr int MA1 = M + 512;
constexpr int NEXP = 32, FF = 1024;
constexpr int MAXTILES = 288;
constexpr float LN_EPS = 1e-5f;
constexpr float DN_ALPHA = 1.189207115002721f;
constexpr float IDX_SCALE = 0.0625f;
constexpr float A_SCALE = 0.125f, C_SCALE = 0.08838834764831845f;
constexpr float SWIGLU_LIMIT = 7.0f, SWIGLU_ALPHA = 1.702f;

enum { I_X = 0, I_MEM, I_LN0G, I_LN0B, I_WIN, I_BIN, I_KVG, I_WUK, I_WUV, I_WOA, I_WDW, I_BDW, I_CLNG, I_CLNB, I_WPW2, I_BPW2,
       I_WMK, I_WMV, I_WOC, I_WOUT, I_BOUT, I_LN1G, I_LN1B, I_WR, I_BR, I_W1, I_B1, I_W2, I_B2, I_LN2G, I_LN2B, N_IN };

constexpr size_t MiB = 1u << 20;
constexpr size_t WS_CTL = 0, CTL_ZERO_BYTES = 1 * MiB;
constexpr size_t WS_WINT = 2 * MiB, WS_WOAT = 16 * MiB, WS_WPW2T = 18 * MiB, WS_WOCT = 19 * MiB, WS_WOUTT = 20 * MiB, WS_BIASP = 22 * MiB;
constexpr size_t WS_KMEM = 23 * MiB, WS_VMEM = 23 * MiB + 512 * 1024;
constexpr size_t WS_W1T = 24 * MiB, WS_W2T = 152 * MiB, WS_XN = 216 * MiB, WS_H1F = 249 * MiB, WS_H1B = 313 * MiB;
constexpr size_t WS_ROWTOK = 346 * MiB, WS_SLOTGATE = 348 * MiB;
constexpr size_t WS_QL = 352 * MiB, WS_CKV = 384 * MiB, WS_KIDX = 388 * MiB, WS_WIDX = 390 * MiB, WS_SSQ = 390 * MiB + 512 * 1024;
constexpr size_t WS_QIDX = 392 * MiB, WS_U = 408 * MiB, WS_QC = 424 * MiB, WS_G = 440 * MiB, WS_OLAT = 536 * MiB, WS_UB = 568 * MiB, WS_OC = 584 * MiB;
constexpr size_t WS_MIXF = 600 * MiB, WS_MIX = 664 * MiB;
constexpr size_t WS_XS = 352 * MiB, WS_HMID = 496 * MiB, WS_Y = 640 * MiB, WS_END = 768 * MiB;
constexpr int CW_CNT = 64;

constexpr int RING_OFF = 0, RING_BYTES = 131072;
constexpr int LDSCTL_OFF = 155648;
constexpr int LDS_BYTES = 163840;

__device__ __forceinline__ float bf2f(unsigned v) { return __uint_as_float(v << 16); }
__device__ __forceinline__ float bflo(unsigned v) { return __uint_as_float(v << 16); }
__device__ __forceinline__ float bfhi(unsigned v) { return __uint_as_float(v & 0xffff0000u); }
__device__ __forceinline__ unsigned f2bf(float f) { unsigned u = __float_as_uint(f); return (u + 0x7fffu + ((u >> 16) & 1u)) >> 16; }
__device__ __forceinline__ unsigned pk2(float lo, float hi) { return f2bf(lo) | (f2bf(hi) << 16); }
typedef _Float16 f16x8 __attribute__((ext_vector_type(8)));
typedef _Float16 f16x2 __attribute__((ext_vector_type(2)));
__device__ __forceinline__ unsigned pkh(float a, float b) { f16x2 v; v.x = (_Float16)a; v.y = (_Float16)b; return __builtin_bit_cast(unsigned, v); }
__device__ __forceinline__ float wave_sum(float v) {
#pragma unroll
    for (int o = 1; o < 64; o <<= 1) v += __shfl_xor(v, o);
    return v;
}
__device__ __forceinline__ float wave_max(float v) {
#pragma unroll
    for (int o = 1; o < 64; o <<= 1) v = fmaxf(v, __shfl_xor(v, o));
    return v;
}
__device__ __forceinline__ int wave_sum_i(int v) {
#pragma unroll
    for (int o = 1; o < 64; o <<= 1) v += __shfl_xor(v, o);
    return v;
}
__device__ __forceinline__ float sigmoidf_fast(float x) { return __builtin_amdgcn_rcpf(1.0f + __expf(-x)); }

struct Args { const float* in[N_IN]; float* out; unsigned char* ws; int ph_lo, ph_hi; };

struct Frame {
    LAS unsigned char* lds;
    int tid, lane, wave, G, bid, vcu;
};

__device__ __forceinline__ void transpose_item(const float* W, int K, int ldN, int col0, int ncols, bf16* WT, int dst_row0, LAS float* scr, int kb, int nb, int lane) {
    const int k0 = 64 * kb, nl = 32 * nb;
    const bool cv = (nl + (lane & 31)) < ncols;
#pragma unroll 8
    for (int i = 0; i < 32; ++i) { const int kk = 2 * i + (lane >> 5); scr[kk * 33 + (lane & 31)] = cv ? W[(size_t)(k0 + kk) * ldN + col0 + nl + (lane & 31)] : 0.f; }
    LDS_WAIT(); asm volatile("" ::: "memory");
    const int c = lane & 7;
#pragma unroll
    for (int j = 0; j < 4; ++j) { const int n = (lane >> 3) + 8 * j; const LAS float* s = scr + (8 * c) * 33 + n;
        v4u o; o.x = pk2(s[0 * 33], s[1 * 33]); o.y = pk2(s[2 * 33], s[3 * 33]); o.z = pk2(s[4 * 33], s[5 * 33]); o.w = pk2(s[6 * 33], s[7 * 33]);
        if (nl + n < ncols) *(v4u*)(WT + (size_t)(dst_row0 + nl + n) * K + k0 + 8 * c) = o; }
    LDS_WAIT(); asm volatile("" ::: "memory");
}
constexpr int seg_items(int K, int nc) { return (K / 64) * ((nc + 31) / 32); }

__device__ __forceinline__ void ln_row_to_bf16(const float* xrow, const float* g, const float* b, bf16* orow, int lane) {
    const f32x4* xr = (const f32x4*)xrow + lane;
    f32x4 v[4]; float s = 0.f;
#pragma unroll
    for (int j = 0; j < 4; ++j) { v[j] = xr[64 * j]; s += (v[j].x + v[j].y) + (v[j].z + v[j].w); }
    const float mean = wave_sum(s) * (1.f / D); float s2 = 0.f;
#pragma unroll
    for (int j = 0; j < 4; ++j) { v[j] = v[j] - mean; s2 += (v[j].x * v[j].x + v[j].y * v[j].y) + (v[j].z * v[j].z + v[j].w * v[j].w); }
    const float rstd = 1.f / sqrtf(wave_sum(s2) * (1.f / D) + LN_EPS);
    unsigned long long* o8 = (unsigned long long*)orow + lane;
#pragma unroll
    for (int j = 0; j < 4; ++j) { const f32x4 gg = ((const f32x4*)g)[64 * j + lane], bb = ((const f32x4*)b)[64 * j + lane];
        const f32x4 y = v[j] * rstd * gg + bb;
        o8[64 * j] = (unsigned long long)pk2(y.x, y.y) | ((unsigned long long)pk2(y.z, y.w) << 32); }
}

__device__ __forceinline__ int proj_src_col(int j) {
    if (j < 1024) return -1;
    if (j < 1280) { const int jj = j - 1024; if (jj < 128) return 512 + jj; if (jj < 160) return 896 + (jj - 128); if (jj < 168) return 928 + (jj - 160); return -1; }
    if (j < 1536) return 640 + (j - 1280);
    if (j < 2560) { const int jj = j - 1536, i = jj >> 8, w = jj & 255; return w < 128 ? 936 + 128 * i + w : 936 + 512 + 128 * i + (w - 128); }
    if (j < 3072) return 1960 + (j - 2560);
    return 2472 + (j - 3072);
}

__device__ __forceinline__ void p0_prologue(const Args& a, Frame& F) {
    unsigned char* ws = a.ws;
    LAS float* scr = (LAS float*)(F.lds + F.wave * 16384);
    const int lane = F.lane;
    const int gw = F.vcu * NWAVES + F.wave, NGW = F.G * NWAVES;
    bf16* WINT = (bf16*)(ws + WS_WINT);
    const float* w_in = a.in[I_WIN];
    for (int m = gw; m < M; m += NGW) ln_row_to_bf16(a.in[I_X] + (size_t)m * D, a.in[I_LN0G], a.in[I_LN0B], (bf16*)(ws + WS_XN) + (size_t)m * D, lane);
    for (int m = gw; m < 512; m += NGW) {
        const f32x4* xr = (const f32x4*)(a.in[I_MEM] + (size_t)m * D) + lane; unsigned long long* o8 = (unsigned long long*)((bf16*)(ws + WS_XN) + (size_t)(M + m) * D) + lane;
#pragma unroll
        for (int j = 0; j < 4; ++j) { const f32x4 y = xr[64 * j]; o8[64 * j] = (unsigned long long)pk2(y.x, y.y) | ((unsigned long long)pk2(y.z, y.w) << 32); }
    }
    for (int m = gw; m < 89; m += NGW) {
        v4u* o = (m < 88) ? (v4u*)(WINT + (size_t)(1024 + 168 + m) * D) : (v4u*)((bf16*)(ws + WS_H1B) + (size_t)M * D);
        o[lane] = (v4u){0, 0, 0, 0}; o[lane + 64] = (v4u){0, 0, 0, 0};
    }
    {
        float* BP = (float*)(ws + WS_BIASP); const float* b_in = a.in[I_BIN];
        for (int j = F.vcu * NTHR + F.tid; j < NB1; j += F.G * NTHR) {
            float v = 0.f;
            if (j < 1024) { const int h = j >> 7, r = j & 127; const float* uk = a.in[I_WUK] + (size_t)(h * 128 + r) * 64; float s = 0.f;
                for (int d = 0; d < 64; ++d) s += b_in[h * 64 + d] * uk[d];
                v = s * a.in[I_KVG][r] * A_SCALE; }
            else if (j < NPROJ) { const int sc = proj_src_col(j); v = sc >= 0 ? b_in[sc] : 0.f; }
            BP[j] = v;
        }
    }
    {
        for (int it = gw; it < 1024; it += NGW) {
            const int h = it >> 7, kblk = (it >> 3) & 15, rblk = it & 7;
            const int k = kblk * 64 + lane; float wv[64];
            const f32x4* src = (const f32x4*)(w_in + (size_t)k * D_IN + h * 64);
#pragma unroll
            for (int d4 = 0; d4 < 16; ++d4) { const f32x4 t4 = src[d4]; wv[4 * d4] = t4.x; wv[4 * d4 + 1] = t4.y; wv[4 * d4 + 2] = t4.z; wv[4 * d4 + 3] = t4.w; }
            for (int rr = 0; rr < 16; ++rr) { const int r = rblk * 16 + rr; const float* uk = a.in[I_WUK] + (size_t)(h * 128 + r) * 64; float s = 0.f;
#pragma unroll
                for (int d = 0; d < 64; ++d) s += wv[d] * uk[d];
                WINT[(size_t)(h * 128 + r) * D + k] = (bf16)f2bf(s * a.in[I_KVG][r] * A_SCALE); }
        }
        bf16* WOAT = (bf16*)(ws + WS_WOAT);
        for (int it = gw; it < 1024; it += NGW) {
            const int h = it >> 7, rblk = (it >> 6) & 1, nblk = it & 63;
            const int r = rblk * 64 + lane; float uv[64];
            const f32x4* src = (const f32x4*)(a.in[I_WUV] + (size_t)(h * 128 + r) * 64);
#pragma unroll
            for (int d4 = 0; d4 < 16; ++d4) { const f32x4 t4 = src[d4]; uv[4 * d4] = t4.x; uv[4 * d4 + 1] = t4.y; uv[4 * d4 + 2] = t4.z; uv[4 * d4 + 3] = t4.w; }
            const float gk = a.in[I_KVG][r];
            for (int nn = 0; nn < 16; ++nn) { const int n = nblk * 16 + nn; const float* oa = a.in[I_WOA] + (size_t)(h * 64) * D + n; float s = 0.f;
#pragma unroll
                for (int d = 0; d < 64; ++d) s += uv[d] * oa[(size_t)d * D];
                WOAT[(size_t)n * D + h * 128 + r] = (bf16)f2bf(s * gk); }
        }
    }
    {
        constexpr int N_SMALL = seg_items(1024, 128) + seg_items(1024, 32) + seg_items(1024, 8) + seg_items(1024, 256) + 8 * seg_items(1024, 128) + seg_items(1024, 512) + seg_items(1024, 3072)
                              + 2 * seg_items(1024, 512) + 2 * seg_items(512, 1024) + seg_items(1024, 1024);
        constexpr int N_W1 = NEXP * 16 * 64, N_W2 = NEXP * 16 * 32;
        constexpr int NITEMS = N_SMALL + N_W1 + N_W2;
#define SEG(Wp, K_, ld_, c0_, nc_, Dp, r0_) { const int nb_ = ((nc_) + 31) / 32, ns_ = ((K_) / 64) * nb_; if (r < ns_) { transpose_item(Wp, K_, ld_, c0_, nc_, Dp, r0_, scr, r / nb_, r % nb_, lane); continue; } r -= ns_; }
        for (int it = gw; it < NITEMS; it += NGW) {
            int r = it;
            SEG(w_in, 1024, D_IN, 512, 128, WINT, 1024);
            SEG(w_in, 1024, D_IN, 896, 32, WINT, 1024 + 128);
            SEG(w_in, 1024, D_IN, 928, 8, WINT, 1024 + 160);
            SEG(w_in, 1024, D_IN, 640, 256, WINT, 1280);
            SEG(w_in, 1024, D_IN, 936, 128, WINT, 1536);
            SEG(w_in, 1024, D_IN, 936 + 512, 128, WINT, 1536 + 128);
            SEG(w_in, 1024, D_IN, 936 + 128, 128, WINT, 1792);
            SEG(w_in, 1024, D_IN, 936 + 512 + 128, 128, WINT, 1792 + 128);
            SEG(w_in, 1024, D_IN, 936 + 256, 128, WINT, 2048);
            SEG(w_in, 1024, D_IN, 936 + 512 + 256, 128, WINT, 2048 + 128);
            SEG(w_in, 1024, D_IN, 936 + 384, 128, WINT, 2304);
            SEG(w_in, 1024, D_IN, 936 + 512 + 384, 128, WINT, 2304 + 128);
            SEG(w_in, 1024, D_IN, 1960, 512, WINT, 2560);
            SEG(w_in, 1024, D_IN, 2472, 3072, WINT, 3072);
            SEG(a.in[I_WMK], 1024, 512, 0, 512, WINT, 6144);
            SEG(a.in[I_WMV], 1024, 512, 0, 512, WINT, 6656);
            SEG(a.in[I_WPW2], 512, 1024, 0, 1024, (bf16*)(ws + WS_WPW2T), 0);
            SEG(a.in[I_WOC], 512, 1024, 0, 1024, (bf16*)(ws + WS_WOCT), 0);
            SEG(a.in[I_WOUT], 1024, 1024, 0, 1024, (bf16*)(ws + WS_WOUTT), 0);
            if (r < N_W1) {
                const int e = r >> 10, kb = (r >> 6) & 15, nb = r & 63, c = 32 * nb;
                const int dr = c < 1024 ? 256 * (c >> 7) + (c & 127) : 256 * ((c - 1024) >> 7) + 128 + ((c - 1024) & 127);
                transpose_item(a.in[I_W1] + (size_t)e * 1024 * 2048, 1024, 2048, c, 32, (bf16*)(ws + WS_W1T), e * 2048 + dr, scr, kb, 0, lane); continue; }
            r -= N_W1;
            { const int e = r >> 9, kb = (r >> 5) & 15, nb = r & 31;
              transpose_item(a.in[I_W2] + (size_t)e * 1024 * 1024, 1024, 1024, 32 * nb, 32, (bf16*)(ws + WS_W2T), e * 1024 + 32 * nb, scr, kb, 0, lane); }
        }
#undef SEG
    }
}

using pg8::Unit; using pg8::StaticOrder;
typedef pg8::f32x4 acc_t[2][2][4][2];

struct ProjOrder : StaticOrder {
    __device__ bool next(int i, Unit& u) const {
        const long L = (long)i * G + c;
        if (L < nwg) return StaticOrder::next(i, u);
        const int e = (int)(L - nwg); if (e >= 8) return false;
        u.pm = 64 + (e >> 2); u.pn = 24 + (e & 3); return true;
    }
};

__device__ __forceinline__ v4u pack8(const f32x4 v0, const f32x4 v1) { v4u w; w.x = pg8::cvt_pk_bf16(v0[0], v0[1]); w.y = pg8::cvt_pk_bf16(v0[2], v0[3]); w.z = pg8::cvt_pk_bf16(v1[0], v1[1]); w.w = pg8::cvt_pk_bf16(v1[2], v1[3]); return w; }
__device__ __forceinline__ f32x4 sig4(const f32x4 v) { f32x4 r; r.x = sigmoidf_fast(v.x); r.y = sigmoidf_fast(v.y); r.z = sigmoidf_fast(v.z); r.w = sigmoidf_fast(v.w); return r; }

struct EpiProj {
    static constexpr bool PERM = true, AFTER_DRAIN = false;
    const float* bias; unsigned char* ws;
    template <bool SIG> __device__ __forceinline__ void store_tile(const acc_t& acc, const f32x4 (&bv)[2][2], bf16* base, int ldc) const {
#pragma unroll
        for (int ai = 0; ai < 2; ++ai)
#pragma unroll
            for (int m = 0; m < 4; ++m) { bf16* rowp = base + (size_t)(ai * 128 + m * 16) * ldc;
#pragma unroll
                for (int bj = 0; bj < 2; ++bj) { f32x4 v0 = acc[ai][bj][m][0] + bv[bj][0], v1 = acc[ai][bj][m][1] + bv[bj][1];
                    if (SIG) { v0 = sig4(v0); v1 = sig4(v1); }
                    *(v4u*)(rowp + bj * 128) = pack8(v0, v1); } }
    }
    __device__ __forceinline__ void operator()(const acc_t& acc, const Unit& u, int wr, int wc, int fr, int fq) const {
        const int pn = u.pn, cl = wc * 32 + 8 * fq;
        const int row0 = u.pm * 256 + wr * 64 + fr;
        f32x4 bv[2][2];
#pragma unroll
        for (int bj = 0; bj < 2; ++bj)
#pragma unroll
            for (int n = 0; n < 2; ++n) bv[bj][n] = *(const f32x4*)(bias + pn * 256 + bj * 128 + cl + 4 * n);
        if (pn < 4) { store_tile<false>(acc, bv, (bf16*)(ws + WS_QL) + (size_t)row0 * 1024 + pn * 256 + cl, 1024); }
        else if (pn == 4) {
            bf16* CKV = (bf16*)(ws + WS_CKV); float* SSQ = (float*)(ws + WS_SSQ); unsigned char* KIDXH = (unsigned char*)(ws + WS_KIDX); float* WIDX = (float*)(ws + WS_WIDX);
#pragma unroll
            for (int ai = 0; ai < 2; ++ai)
#pragma unroll
                for (int m = 0; m < 4; ++m) { const size_t row = (size_t)row0 + ai * 128 + m * 16;
                    const f32x4 v0 = acc[ai][0][m][0] + bv[0][0], v1 = acc[ai][0][m][1] + bv[0][1];
                    *(v4u*)(CKV + row * 128 + cl) = pack8(v0, v1);
                    float ss = (v0.x * v0.x + v0.y * v0.y) + (v0.z * v0.z + v0.w * v0.w) + (v1.x * v1.x + v1.y * v1.y) + (v1.z * v1.z + v1.w * v1.w);
                    ss += __shfl_xor(ss, 16); ss += __shfl_xor(ss, 32);
                    if (fq == 0) SSQ[row * 4 + wc] = ss;
                    const f32x4 k0 = acc[ai][1][m][0] + bv[1][0], k1 = acc[ai][1][m][1] + bv[1][1];
                    if (wc == 0) { v4u kh; kh.x = pkh(k0.x, k0.y); kh.y = pkh(k0.z, k0.w); kh.z = pkh(k1.x, k1.y); kh.w = pkh(k1.z, k1.w);
                        *(v4u*)(KIDXH + (row >> 4) * 1024 + (size_t)(fq * 16 + (row & 15)) * 16) = kh; }
                    else if (wc == 1 && fq == 0) { *(f32x4*)(WIDX + row * 8) = k0; *(f32x4*)(WIDX + row * 8 + 4) = k1; } }
        }
        else if (pn == 5) {
            unsigned char* QIDXH = (unsigned char*)(ws + WS_QIDX);
#pragma unroll
            for (int ai = 0; ai < 2; ++ai)
#pragma unroll
                for (int m = 0; m < 4; ++m) { unsigned char* rowp = QIDXH + ((size_t)row0 + ai * 128 + m * 16) * 512 + cl * 2;
#pragma unroll
                    for (int bj = 0; bj < 2; ++bj) { const f32x4 v0 = acc[ai][bj][m][0] + bv[bj][0], v1 = acc[ai][bj][m][1] + bv[bj][1];
                        v4u qh; qh.x = pkh(v0.x, v0.y); qh.y = pkh(v0.z, v0.w); qh.z = pkh(v1.x, v1.y); qh.w = pkh(v1.z, v1.w);
                        *(v4u*)(rowp + bj * 256) = qh; } }
        }
        else if (pn < 10) {
            bf16* U = (bf16*)(ws + WS_U) + (size_t)row0 * 512 + (pn - 6) * 128 + cl;
#pragma unroll
            for (int ai = 0; ai < 2; ++ai)
#pragma unroll
                for (int m = 0; m < 4; ++m) {
                    const f32x4 a0 = acc[ai][0][m][0] + bv[0][0], a1 = acc[ai][0][m][1] + bv[0][1];
                    const f32x4 g0 = sig4(acc[ai][1][m][0] + bv[1][0]), g1 = sig4(acc[ai][1][m][1] + bv[1][1]);
                    *(v4u*)(U + (size_t)(ai * 128 + m * 16) * 512) = pack8(a0 * g0, a1 * g1); }
        }
        else if (pn < 12) { store_tile<false>(acc, bv, (bf16*)(ws + WS_QC) + (size_t)row0 * 512 + (pn - 10) * 256 + cl, 512); }
        else if (pn < 24) { store_tile<true>(acc, bv, (bf16*)(ws + WS_G) + (size_t)row0 * 3072 + (pn - 12) * 256 + cl, 3072); }
        else {
            const int rm = row0 - M; bf16* base = (bf16*)(ws + (pn < 26 ? WS_KMEM : WS_VMEM)) + (size_t)rm * 512 + ((pn - 24) & 1) * 256 + cl;
            store_tile<false>(acc, bv, base, 512);
        }
    }
};

template <int SEG> struct EpiMix {
    static constexpr bool PERM = false, AFTER_DRAIN = false;
    const float* bias; unsigned char* ws;
    __device__ __forceinline__ void operator()(const acc_t& acc, const Unit& u, int wr, int wc, int fr, int fq) const {
        const int col0 = u.pn * 256 + wc * 32 + 4 * fq;
        const bf16* G = (const bf16*)(ws + WS_G); float* MIXF = (float*)(ws + WS_MIXF); bf16* MIX = (bf16*)(ws + WS_MIX);
#pragma unroll
        for (int ai = 0; ai < 2; ++ai)
#pragma unroll
            for (int m = 0; m < 4; ++m) { const size_t row = (size_t)u.pm * 256 + ai * 128 + wr * 64 + m * 16 + fr;
#pragma unroll
                for (int bj = 0; bj < 2; ++bj)
#pragma unroll
                    for (int n = 0; n < 2; ++n) { const int col = col0 + bj * 128 + n * 16;
                        const v2u gw = *(const v2u*)(G + row * 3072 + SEG * 1024 + col);
                        const f32x4 g = (f32x4){bflo(gw.x), bfhi(gw.x), bflo(gw.y), bfhi(gw.y)};
                        f32x4 v = acc[ai][bj][m][n];
                        if (SEG == 1) v = v + *(const f32x4*)(bias + col);
                        v = v * g;
                        if (SEG > 0) v = v + *(const f32x4*)(MIXF + row * 1024 + col);
                        if (SEG < 2) *(f32x4*)(MIXF + row * 1024 + col) = v;
                        else { v2u o; o.x = pg8::cvt_pk_bf16(v.x, v.y); o.y = pg8::cvt_pk_bf16(v.z, v.w); *(v2u*)(MIX + row * 1024 + col) = o; } } }
    }
};

struct EpiOut {
    static constexpr bool PERM = false, AFTER_DRAIN = false;
    const float* bias; unsigned char* ws;
    __device__ __forceinline__ void operator()(const acc_t& acc, const Unit& u, int wr, int wc, int fr, int fq) const {
        const int col0 = u.pn * 256 + wc * 32 + 4 * fq;
        const bf16* XN = (const bf16*)(ws + WS_XN); float* S1 = (float*)(ws + WS_H1F);
#pragma unroll
        for (int ai = 0; ai < 2; ++ai)
#pragma unroll
            for (int m = 0; m < 4; ++m) { const size_t row = (size_t)u.pm * 256 + ai * 128 + wr * 64 + m * 16 + fr;
#pragma unroll
                for (int bj = 0; bj < 2; ++bj)
#pragma unroll
                    for (int n = 0; n < 2; ++n) { const int col = col0 + bj * 128 + n * 16;
                        const v2u hw = *(const v2u*)(XN + row * 1024 + col);
                        const f32x4 h = (f32x4){bflo(hw.x), bfhi(hw.x), bflo(hw.y), bfhi(hw.y)};
                        *(f32x4*)(S1 + row * 1024 + col) = h * DN_ALPHA + acc[ai][bj][m][n] + *(const f32x4*)(bias + col); } }
    }
};

template <int NT> struct MoeOrder {
    const LAS int* tstart; int G, c;
    __device__ bool next(int i, Unit& u) const {
        const int L = i * G + c; if (L >= NT * tstart[NEXP]) return false;
        int e = 0; while (e < NEXP - 1 && L >= NT * tstart[e + 1]) ++e;
        const int te = tstart[e + 1] - tstart[e], idx = L - NT * tstart[e];
        u.pn = e * NT + idx / te; u.pm = tstart[e] + idx % te; return true;
    }
    __device__ __forceinline__ void a_ready(const Unit&) const {}
    __device__ __forceinline__ void done(const Unit&) const {}
};
struct EpiMoe1 {
    static constexpr bool PERM = true, AFTER_DRAIN = false;
    const float* b1; unsigned char* ws;
    __device__ __forceinline__ void operator()(const acc_t& acc, const Unit& u, int wr, int wc, int fr, int fq) const {
        const int e = u.pn >> 3, j = u.pn & 7, cl = wc * 32 + 8 * fq;
        const float* bg = b1 + (size_t)e * 2048 + j * 128 + cl; const float* bu = bg + 1024;
        const f32x4 bg0 = *(const f32x4*)bg, bg1 = *(const f32x4*)(bg + 4), bu0 = *(const f32x4*)bu, bu1 = *(const f32x4*)(bu + 4);
        bf16* H = (bf16*)(ws + WS_HMID) + ((size_t)u.pm * 256 + wr * 64 + fr) * 1024 + j * 128 + cl;
#pragma unroll
        for (int ai = 0; ai < 2; ++ai)
#pragma unroll
            for (int m = 0; m < 4; ++m) { f32x4 o[2];
#pragma unroll
                for (int n = 0; n < 2; ++n) { const f32x4 g = acc[ai][0][m][n] + (n ? bg1 : bg0), uu = acc[ai][1][m][n] + (n ? bu1 : bu0);
#pragma unroll
                    for (int q = 0; q < 4; ++q) { const float gc = fminf(g[q], SWIGLU_LIMIT), uc = fminf(fmaxf(uu[q], -SWIGLU_LIMIT), SWIGLU_LIMIT);
                        o[n][q] = (uc + 1.0f) * (gc * sigmoidf_fast(SWIGLU_ALPHA * gc)); } }
                *(v4u*)(H + (size_t)(ai * 128 + m * 16) * 1024) = pack8(o[0], o[1]); }
    }
};
struct EpiMoe2 {
    static constexpr bool PERM = true, AFTER_DRAIN = false;
    const float* b2; unsigned char* ws; const LAS int* tstart; const LAS int* cntl;
    __device__ __forceinline__ void operator()(const acc_t& acc, const Unit& u, int wr, int wc, int fr, int fq) const {
        const int e = u.pn >> 2, j = u.pn & 3, cl = wc * 32 + 8 * fq;
        const int p0 = (u.pm - tstart[e]) * 256 + wr * 64 + fr, ce = cntl[e];
        const int* ROWTOK = (const int*)(ws + WS_ROWTOK) + (size_t)e * M; const float* SG = (const float*)(ws + WS_SLOTGATE);
        bf16* Y = (bf16*)(ws + WS_Y);
        f32x4 bv[2][2];
#pragma unroll
        for (int bj = 0; bj < 2; ++bj)
#pragma unroll
            for (int n = 0; n < 2; ++n) bv[bj][n] = *(const f32x4*)(b2 + (size_t)e * 1024 + j * 256 + bj * 128 + cl + 4 * n);
#pragma unroll
        for (int ai = 0; ai < 2; ++ai)
#pragma unroll
            for (int m = 0; m < 4; ++m) { const int p = p0 + ai * 128 + m * 16;
                if (p < ce) { const int slot = ROWTOK[p]; const float gate = SG[slot]; bf16* yp = Y + (size_t)slot * 1024 + j * 256 + cl;
#pragma unroll
                    for (int bj = 0; bj < 2; ++bj) *(v4u*)(yp + bj * 128) = pack8((acc[ai][bj][m][0] + bv[bj][0]) * gate, (acc[ai][bj][m][1] + bv[bj][1]) * gate); } }
    }
};

typedef short bf16x8v __attribute__((ext_vector_type(8)));
typedef unsigned u32x32 __attribute__((ext_vector_type(32)));
__device__ __forceinline__ unsigned okey(float s) { const unsigned b = __float_as_uint(s); return (b & 0x80000000u) ? ~b : (b | 0x80000000u); }
__device__ __forceinline__ unsigned off_a(unsigned row, unsigned ch) { return 2048u * (row >> 3) + 512u * (ch >> 2) + 64u * (row & 7) + 16u * ((ch & 3) ^ ((row >> 2) & 3)); }
__device__ __forceinline__ int mbcnt64(unsigned long long m) { return (int)__builtin_amdgcn_mbcnt_hi((unsigned)(m >> 32), __builtin_amdgcn_mbcnt_lo((unsigned)m, 0u)); }

constexpr int DSA_KT_BYTES = 32768;
constexpr int DSA_WAVE_OFF = 65536, DSA_WAVE_BYTES = 11264;

#define DSA_COUNT_GE(cand, dst) do { int cnt_ = 0; \
    _Pragma("unroll") for (int r_ = 0; r_ < 32; ++r_) { if ((r_ & 7) == 0 && r_ > c) break; cnt_ += __builtin_popcountll(__ballot(s0[r_] >= (cand))); } \
    if (c >= 32) { _Pragma("unroll") for (int r_ = 0; r_ < 32; ++r_) { if ((r_ & 7) == 0 && r_ + 32 > c) break; cnt_ += __builtin_popcountll(__ballot(s1[r_] >= (cand))); } } \
    if (c >= 64) { _Pragma("unroll") for (int r_ = 0; r_ < 32; ++r_) { if ((r_ & 7) == 0 && r_ + 64 > c) break; cnt_ += __builtin_popcountll(__ballot(s2[r_] >= (cand))); } } \
    if (c >= 96) { _Pragma("unroll") for (int r_ = 0; r_ < 32; ++r_) { if ((r_ & 7) == 0 && r_ + 96 > c) break; cnt_ += __builtin_popcountll(__ballot(s3[r_] >= (cand))); } } \
    dst = cnt_; } while (0)

#define DSA_SCORE_GROUP(SV, GRP) \
    for (int kt = 4 * (GRP); kt < nt && kt < 4 * (GRP) + 4; ++kt) { \
        if (kt + 1 < nt) { const v4u* src = (const v4u*)(kbase + (size_t)(kt + 1) * DSA_KT_BYTES) + tid; \
            _Pragma("unroll") for (int i = 0; i < 4; ++i) kpre[i] = src[i * NTHR]; } \
        const LAS unsigned char* kb = F.lds + (kt & 1) * DSA_KT_BYTES + lane * 16; \
        const int nblk = (c + 1 - 8 * kt) < 8 ? (c + 1 - 8 * kt) : 8; \
        for (int bi = 0; bi < nblk; ++bi) { \
            float pp[4]; \
            _Pragma("unroll") for (int g4 = 0; g4 < 4; ++g4) { \
                const f16x8 bf = *(const LAS f16x8*)(kb + (bi * 4 + g4) * 1024); \
                const f32x4 cc = __builtin_amdgcn_mfma_f32_16x16x32_f16(af, bf, (f32x4){0.f, 0.f, 0.f, 0.f}, 0, 0, 0); \
                pp[g4] = wl[0] * fmaxf(cc.x, 0.f) + wl[1] * fmaxf(cc.y, 0.f) + wl[2] * fmaxf(cc.z, 0.f) + wl[3] * fmaxf(cc.w, 0.f); } \
            const float keep = lb1 ? (lb0 ? pp[3] : pp[2]) : (lb0 ? pp[1] : pp[0]); \
            const float send = lb1 ? (lb0 ? pp[2] : pp[3]) : (lb0 ? pp[0] : pp[1]); \
            const float recv = __int_as_float(__builtin_amdgcn_ds_swizzle(__float_as_int(send), 0x401F)); \
            SV[8 * (kt & 3) + bi] = okey((keep + recv) + 0.0f); } \
        if (kt + 1 < nt) { LAS v4u* dst = (LAS v4u*)(F.lds + ((kt + 1) & 1) * DSA_KT_BYTES) + tid; \
            _Pragma("unroll") for (int i = 0; i < 4; ++i) dst[i * NTHR] = kpre[i]; } \
        __syncthreads(); }

#define DSA_COMPACT_GROUP(SV, GRP) \
    _Pragma("unroll") for (int r_ = 0; r_ < 32; ++r_) { if ((r_ & 7) == 0 && r_ + 32 * (GRP) > c) break; \
        const unsigned ok_ = SV[r_]; const bool gt_ = ok_ > tau, eq_ = ok_ == tau; \
        const unsigned long long meq_ = __ballot(eq_); \
        const bool sb_ = gt_ || (eq_ && mbcnt64(meq_) < need_left); \
        const int neq_ = __builtin_popcountll(meq_); need_left -= neq_ < need_left ? neq_ : need_left; \
        const unsigned long long ms_ = __ballot(sb_); \
        if (sb_) sel[base + mbcnt64(ms_)] = 64 * (r_ + 32 * (GRP)) + lane; \
        base += __builtin_popcountll(ms_); }

__device__ __forceinline__ void dsa_phase(const Args& a, Frame& F) {
    unsigned char* ws = a.ws;
    const int tid = F.tid, lane = F.lane, wave = F.wave;
    const unsigned char* QIDXH = (const unsigned char*)(ws + WS_QIDX); const unsigned char* KIDXH = (const unsigned char*)(ws + WS_KIDX); const float* WIDX = (const float*)(ws + WS_WIDX);
    const bf16* QL = (const bf16*)(ws + WS_QL); const bf16* CKV = (const bf16*)(ws + WS_CKV); const float* SSQ = (const float*)(ws + WS_SSQ);
    bf16* OLAT = (bf16*)(ws + WS_OLAT);
    LAS unsigned char* wbase = F.lds + DSA_WAVE_OFF + wave * DSA_WAVE_BYTES;
    LAS int* sel = (LAS int*)(wbase + 8192); LAS float* skl = (LAS float*)(wbase + 9216); LAS float* dl = (LAS float*)(wbase + 10240);
    const bool lb0 = (lane & 16) != 0, lb1 = (lane & 32) != 0;
    const int g = lane >> 4, fr = lane & 15;
    const unsigned vt = (unsigned)(size_t)wbase;
    unsigned trb[2][2]; const LAS unsigned char* rrp[2];
#pragma unroll
    for (int u = 0; u < 2; ++u) rrp[u] = wbase + off_a(8 * (fr >> 2) + 4 * u + (fr & 3), g);
    { const unsigned q = (unsigned)fr >> 2, p = lane & 3;
#pragma unroll
      for (int t = 0; t < 2; ++t)
#pragma unroll
        for (int c1 = 0; c1 < 2; ++c1) trb[t][c1] = vt + off_a(8 * g + 4 * t + q, 2 * c1 + (p >> 1)) + 8 * (p & 1); }
    const float slope = exp2f(-(float)((fr & 7) + 1));
    for (int j = F.bid; j < 256; j += F.G) {
    const int b = j & 1, e = (j >> 1) & 7, pc = j >> 4;
    for (int ui = 0; ui < 8; ++ui) {
        const int c = (ui & 1) ? (32 * (ui >> 1) + 31 - pc) : (32 * (ui >> 1) + pc);
        const int t = 64 * c + 8 * e + wave, q = b * T + t;
        int nsel;
        if (c >= 4) {
            u32x32 s0, s1, s2, s3;
#pragma unroll
            for (int i = 0; i < 32; ++i) { s0[i] = 0u; s1[i] = 0u; s2[i] = 0u; s3[i] = 0u; }
            const f16x8 af = *(const f16x8*)(QIDXH + (size_t)q * 512 + (fr & 7) * 64 + g * 16);
            float wl[4];
            { const f32x4 w4 = *(const f32x4*)(WIDX + (size_t)q * 8 + 4 * (g & 1)); wl[0] = w4.x * IDX_SCALE; wl[1] = w4.y * IDX_SCALE; wl[2] = w4.z * IDX_SCALE; wl[3] = w4.w * IDX_SCALE; }
            const int nt = (c + 8) >> 3;
            const unsigned char* kbase = KIDXH + (size_t)b * T * 64;
            v4u kpre[4];
            { const v4u* src = (const v4u*)kbase + tid; LAS v4u* dst = (LAS v4u*)(F.lds) + tid;
#pragma unroll
              for (int i = 0; i < 4; ++i) kpre[i] = src[i * NTHR];
#pragma unroll
              for (int i = 0; i < 4; ++i) dst[i * NTHR] = kpre[i]; }
            __syncthreads();
            DSA_SCORE_GROUP(s0, 0)
            DSA_SCORE_GROUP(s1, 1)
            DSA_SCORE_GROUP(s2, 2)
            DSA_SCORE_GROUP(s3, 3)
            unsigned tau = 0u;
            for (int bit = 31; bit >= 0; --bit) { const unsigned cand = tau | (1u << bit); int cnt; DSA_COUNT_GE(cand, cnt); if (cnt >= 256) tau = cand; }
            int cgt; { const unsigned t1 = tau + 1u; if (t1 == 0u) cgt = 0; else DSA_COUNT_GE(t1, cgt); }
            int need_left = 256 - cgt, base = 0;
            DSA_COMPACT_GROUP(s0, 0)
            if (c >= 32) { DSA_COMPACT_GROUP(s1, 1) }
            if (c >= 64) { DSA_COMPACT_GROUP(s2, 2) }
            if (c >= 96) { DSA_COMPACT_GROUP(s3, 3) }
            nsel = 256;
        } else {
            nsel = 64 * (c + 1);
#pragma unroll
            for (int i = 0; i < 4; ++i) if (lane + 64 * i < nsel) sel[lane + 64 * i] = lane + 64 * i;
        }
#pragma unroll
        for (int i = 0; i < 4; ++i) { const int pos = lane + 64 * i;
            if (pos < nsel) { const int key = sel[pos]; const f32x4 s4 = *(const f32x4*)(SSQ + (size_t)(b * T + key) * 4);
                skl[pos] = 1.0f / sqrtf(((s4.x + s4.y) + (s4.z + s4.w)) * (1.0f / 128.0f) + LN_EPS);
                dl[pos] = (float)(t > key ? t - key : key - t); } }
        bf16x8v qf[4];
#pragma unroll
        for (int ks = 0; ks < 4; ++ks) qf[ks] = *(const bf16x8v*)(QL + (size_t)q * 1024 + (fr & 7) * 128 + 32 * ks + 8 * g);
        f32x4 oacc[8];
#pragma unroll
        for (int i = 0; i < 8; ++i) oacc[i] = (f32x4){0.f, 0.f, 0.f, 0.f};
        float mrun = -1.0e30f, lrun = 0.f;
        const int ntile = nsel >> 5;
        v4u rowpre[8];
#pragma unroll
        for (int i = 0; i < 8; ++i) { const int n = lane + 64 * i; const int key = sel[n >> 4]; rowpre[i] = *(const v4u*)(CKV + (size_t)(b * T + key) * 128 + (n & 15) * 8); }
        for (int tI = 0; tI < ntile; ++tI) {
#pragma unroll
            for (int i = 0; i < 8; ++i) { const unsigned n = lane + 64 * i, p = n >> 4, ch = n & 15; const unsigned R = 8 * ((p & 15) >> 2) + 4 * (p >> 4) + (p & 3);
                *(LAS v4u*)(wbase + off_a(R, ch)) = rowpre[i]; }
            if (tI + 1 < ntile) {
#pragma unroll
                for (int i = 0; i < 8; ++i) { const int n = lane + 64 * i; const int key = sel[32 * (tI + 1) + (n >> 4)]; rowpre[i] = *(const v4u*)(CKV + (size_t)(b * T + key) * 128 + (n & 15) * 8); }
            }
            float sv[2][4];
#pragma unroll
            for (int u = 0; u < 2; ++u) { f32x4 acc = (f32x4){0.f, 0.f, 0.f, 0.f};
#pragma unroll
                for (int ks = 0; ks < 4; ++ks) { const bf16x8v ka = *(const LAS bf16x8v*)(rrp[u] + 512 * ks); acc = __builtin_amdgcn_mfma_f32_16x16x32_bf16(ka, qf[ks], acc, 0, 0, 0); }
                const f32x4 sk4 = *(const LAS f32x4*)(skl + 32 * tI + 16 * u + 4 * g), d4 = *(const LAS f32x4*)(dl + 32 * tI + 16 * u + 4 * g);
                sv[u][0] = acc.x * sk4.x - slope * d4.x; sv[u][1] = acc.y * sk4.y - slope * d4.y; sv[u][2] = acc.z * sk4.z - slope * d4.z; sv[u][3] = acc.w * sk4.w - slope * d4.w;
                }
            float tmax = fmaxf(fmaxf(fmaxf(sv[0][0], sv[0][1]), fmaxf(sv[0][2], sv[0][3])), fmaxf(fmaxf(sv[1][0], sv[1][1]), fmaxf(sv[1][2], sv[1][3])));
            tmax = fmaxf(tmax, __shfl_xor(tmax, 16)); tmax = fmaxf(tmax, __shfl_xor(tmax, 32));
            const float mnew = fmaxf(mrun, tmax), alpha = __expf(mrun - mnew);
            mrun = mnew;
            float psum = 0.f; float pv[2][4];
#pragma unroll
            for (int u = 0; u < 2; ++u)
#pragma unroll
                for (int i = 0; i < 4; ++i) { pv[u][i] = __expf(sv[u][i] - mnew); psum += pv[u][i]; }
            lrun = lrun * alpha + psum;
            { const f32x4 ska = *(const LAS f32x4*)(skl + 32 * tI + 4 * g), skb = *(const LAS f32x4*)(skl + 32 * tI + 16 + 4 * g);
              pv[0][0] *= ska.x; pv[0][1] *= ska.y; pv[0][2] *= ska.z; pv[0][3] *= ska.w; pv[1][0] *= skb.x; pv[1][1] *= skb.y; pv[1][2] *= skb.z; pv[1][3] *= skb.w; }
            v4u pw; pw.x = pg8::cvt_pk_bf16(pv[0][0], pv[0][1]); pw.y = pg8::cvt_pk_bf16(pv[0][2], pv[0][3]); pw.z = pg8::cvt_pk_bf16(pv[1][0], pv[1][1]); pw.w = pg8::cvt_pk_bf16(pv[1][2], pv[1][3]);
            const bf16x8v pfrag = __builtin_bit_cast(bf16x8v, pw);
#pragma unroll
            for (int i = 0; i < 8; ++i) oacc[i] = oacc[i] * alpha;
#define DSA_TR8(HF, OFF0, OFF1) { v2u a0[4], a1[4]; \
                asm volatile("ds_read_b64_tr_b16 %0, %8 offset:" #OFF0 "\n\tds_read_b64_tr_b16 %1, %9 offset:" #OFF0 "\n\tds_read_b64_tr_b16 %2, %10 offset:" #OFF0 "\n\tds_read_b64_tr_b16 %3, %11 offset:" #OFF0 "\n\t" \
                             "ds_read_b64_tr_b16 %4, %8 offset:" #OFF1 "\n\tds_read_b64_tr_b16 %5, %9 offset:" #OFF1 "\n\tds_read_b64_tr_b16 %6, %10 offset:" #OFF1 "\n\tds_read_b64_tr_b16 %7, %11 offset:" #OFF1 "\n\t" \
                             "s_waitcnt lgkmcnt(0)" \
                             : "=&v"(a0[0]), "=&v"(a1[0]), "=&v"(a0[1]), "=&v"(a1[1]), "=&v"(a0[2]), "=&v"(a1[2]), "=&v"(a0[3]), "=&v"(a1[3]) \
                             : "v"(trb[0][0]), "v"(trb[1][0]), "v"(trb[0][1]), "v"(trb[1][1]) : "memory"); \
                _Pragma("unroll") for (int cc = 0; cc < 4; ++cc) { v4u aw; aw.x = a0[cc].x; aw.y = a0[cc].y; aw.z = a1[cc].x; aw.w = a1[cc].y; \
                    oacc[4 * (HF) + cc] = __builtin_amdgcn_mfma_f32_16x16x32_bf16(__builtin_bit_cast(bf16x8v, aw), pfrag, oacc[4 * (HF) + cc], 0, 0, 0); } }
            DSA_TR8(0, 0, 512)
            DSA_TR8(1, 1024, 1536)
#undef DSA_TR8
        }
        lrun += __shfl_xor(lrun, 16); lrun += __shfl_xor(lrun, 32);
        const float inv = 1.0f / lrun;
        if (fr < 8) {
#pragma unroll
            for (int i = 0; i < 8; ++i) { v2u o; o.x = pg8::cvt_pk_bf16(oacc[i].x * inv, oacc[i].y * inv); o.y = pg8::cvt_pk_bf16(oacc[i].z * inv, oacc[i].w * inv);
                *(v2u*)(OLAT + (size_t)q * 1024 + fr * 128 + 16 * i + 4 * g) = o; }
        }
    }
}
}

__device__ __forceinline__ void conv_phase(const Args& a, Frame& F) {
    unsigned char* ws = a.ws;
    LAS unsigned* Uin = (LAS unsigned*)(F.lds);
    LAS float* CT = (LAS float*)(F.lds + 65536);
    const bf16* U = (const bf16*)(ws + WS_U); bf16* UB = (bf16*)(ws + WS_UB);
    const int tid = F.tid, lane = F.lane, wave = F.wave;
    const int cp = tid & 255, th = tid >> 8;
    float w0[31], w1[31];
#pragma unroll
    for (int j = 0; j < 31; ++j) { const f32x2 w = *(const f32x2*)(a.in[I_WDW] + j * 512 + 2 * cp); w0[j] = w.x; w1[j] = w.y; }
    const f32x2 bd = *(const f32x2*)(a.in[I_BDW] + 2 * cp);
    for (int un = F.bid; un < M / 32; un += F.G) {
        const int b = un / (T / 32), t0 = (un % (T / 32)) * 32;
        for (int idx = tid; idx < 62 * 64; idx += NTHR) { const int rr = idx >> 6, ch = idx & 63, tt = t0 - 30 + rr;
            v4u v = (v4u){0, 0, 0, 0}; if (tt >= 0) v = *(const v4u*)(U + ((size_t)(b * T + tt)) * 512 + ch * 8);
            *(LAS v4u*)(Uin + rr * 256 + ch * 4) = v; }
        __syncthreads();
        for (int tt = 0; tt < 16; ++tt) { const int t = th * 16 + tt; float a0 = bd.x, a1 = bd.y;
#pragma unroll
            for (int j = 0; j < 31; ++j) { const unsigned v = Uin[(t + j) * 256 + cp]; a0 += w0[j] * bflo(v); a1 += w1[j] * bfhi(v); }
            *(LAS f32x2*)(CT + t * 512 + 2 * cp) = (f32x2){a0, a1}; }
        __syncthreads();
#pragma unroll
        for (int rr = 0; rr < 4; ++rr) { const int row = wave * 4 + rr; const LAS float* cr = CT + row * 512 + 8 * lane;
            f32x4 x0 = *(const LAS f32x4*)cr, x1 = *(const LAS f32x4*)(cr + 4);
            const float mean = wave_sum((x0.x + x0.y) + (x0.z + x0.w) + (x1.x + x1.y) + (x1.z + x1.w)) * (1.0f / 512.0f);
            x0 = x0 - mean; x1 = x1 - mean;
            const float var = wave_sum((x0.x * x0.x + x0.y * x0.y) + (x0.z * x0.z + x0.w * x0.w) + (x1.x * x1.x + x1.y * x1.y) + (x1.z * x1.z + x1.w * x1.w)) * (1.0f / 512.0f);
            const float rstd = 1.0f / sqrtf(var + LN_EPS);
            const f32x4 g0 = *(const f32x4*)(a.in[I_CLNG] + 8 * lane), g1 = *(const f32x4*)(a.in[I_CLNG] + 8 * lane + 4);
            const f32x4 b0 = *(const f32x4*)(a.in[I_CLNB] + 8 * lane), b1 = *(const f32x4*)(a.in[I_CLNB] + 8 * lane + 4);
            f32x4 y0 = x0 * rstd * g0 + b0, y1 = x1 * rstd * g1 + b1;
            y0 = y0 * sig4(y0); y1 = y1 * sig4(y1);
            *(v4u*)(UB + ((size_t)(b * T + t0 + row)) * 512 + 8 * lane) = pack8(y0, y1); }
        __syncthreads();
    }
}

__device__ __forceinline__ void memattn_phase(const Args& a, Frame& F) {
    unsigned char* ws = a.ws;
    constexpr int KP = 136;
    LAS bf16* Kl = (LAS bf16*)(F.lds);
    LAS bf16* Vl = (LAS bf16*)(F.lds + 256 * KP * 2);
    LAS float* qs = (LAS float*)(F.lds + 256 * KP * 2 + 65536);
    LAS float* ps = qs + 8 * 128;
    const bf16* KM = (const bf16*)(ws + WS_KMEM); const bf16* VM = (const bf16*)(ws + WS_VMEM); const bf16* QC = (const bf16*)(ws + WS_QC); bf16* OC = (bf16*)(ws + WS_OC);
    const int tid = F.tid, lane = F.lane, wave = F.wave;
    for (int un = F.bid; un < 256; un += F.G) {
        const int b = un >> 7, h = (un >> 5) & 3, t0 = (un & 31) * 256;
        for (int idx = tid; idx < 256 * 16; idx += NTHR) { const int mrow = idx >> 4, ch = idx & 15;
            *(LAS v4u*)(Kl + mrow * KP + ch * 8) = *(const v4u*)(KM + (size_t)(b * 256 + mrow) * 512 + h * 128 + ch * 8);
            *(LAS v4u*)(Vl + mrow * 128 + ch * 8) = *(const v4u*)(VM + (size_t)(b * 256 + mrow) * 512 + h * 128 + ch * 8); }
        __syncthreads();
        for (int tk = wave; tk < 256; tk += NWAVES) {
            const size_t row = (size_t)(b * T + t0 + tk);
            const unsigned qw = *(const unsigned*)(QC + row * 512 + h * 128 + 2 * lane);
            *(LAS f32x2*)(qs + wave * 128 + 2 * lane) = (f32x2){bflo(qw), bfhi(qw)};
            LDS_WAIT(); asm volatile("" ::: "memory");
            float lg[4]; float mx = -3.0e38f;
#pragma unroll
            for (int j = 0; j < 4; ++j) { const int mrow = lane + 64 * j; float d = 0.f;
#pragma unroll
                for (int c8 = 0; c8 < 16; ++c8) { const v4u w = *(const LAS v4u*)(Kl + mrow * KP + c8 * 8); const LAS float* qq = qs + wave * 128 + c8 * 8;
                    const f32x4 q0 = *(const LAS f32x4*)qq, q1 = *(const LAS f32x4*)(qq + 4);
                    d += bflo(w.x) * q0.x + bfhi(w.x) * q0.y + bflo(w.y) * q0.z + bfhi(w.y) * q0.w + bflo(w.z) * q1.x + bfhi(w.z) * q1.y + bflo(w.w) * q1.z + bfhi(w.w) * q1.w; }
                lg[j] = d * C_SCALE; mx = fmaxf(mx, lg[j]); }
            mx = wave_max(mx); float s = 0.f;
#pragma unroll
            for (int j = 0; j < 4; ++j) { lg[j] = __expf(lg[j] - mx); s += lg[j]; }
            s = wave_sum(s); const float inv = 1.0f / s;
#pragma unroll
            for (int j = 0; j < 4; ++j) ps[wave * 256 + lane + 64 * j] = lg[j] * inv;
            LDS_WAIT(); asm volatile("" ::: "memory");
            float o0 = 0.f, o1 = 0.f;
#pragma unroll 8
            for (int mrow = 0; mrow < 256; ++mrow) { const float p = ps[wave * 256 + mrow]; const unsigned w = *(const LAS unsigned*)(Vl + mrow * 128 + 2 * lane); o0 += p * bflo(w); o1 += p * bfhi(w); }
            *(unsigned*)(OC + row * 512 + h * 128 + 2 * lane) = pk2(o0, o1);
            LDS_WAIT(); asm volatile("" ::: "memory");
        }
        __syncthreads();
    }
}

__device__ __forceinline__ void router_phase(const Args& a, Frame& F) {
    unsigned char* ws = a.ws;
    LAS float* WRT = (LAS float*)(F.lds);
    LAS int* cntL = (LAS int*)(F.lds + 131072);
    LAS int* baseL = cntL + 32;
    LAS int* tokE = baseL + 32;
    LAS int* tokP = tokE + 256;
    const int tid = F.tid, lane = F.lane, wave = F.wave;
    float* H1F = (float*)(ws + WS_H1F); bf16* H1B = (bf16*)(ws + WS_H1B); float* SG = (float*)(ws + WS_SLOTGATE); int* ROWTOK = (int*)(ws + WS_ROWTOK);
    unsigned* cnt = (unsigned*)(ws + WS_CTL) + CW_CNT;
    for (int idx = tid; idx < 32768; idx += NTHR) { const int i = idx >> 5, e = idx & 31; WRT[e * 1024 + i] = a.in[I_WR][idx]; }
    for (int blk = F.bid; blk < M / 64; blk += F.G) {
        if (tid < 32) cntL[tid] = 0;
        __syncthreads();
        for (int tk = wave; tk < 64; tk += NWAVES) {
            const int tokl = tk, token = blk * 64 + tokl;
            float* srow = H1F + (size_t)token * D;
            f32x4 v[4]; float s = 0.f;
#pragma unroll
            for (int j = 0; j < 4; ++j) { v[j] = ((const f32x4*)srow)[64 * j + lane]; s += (v[j].x + v[j].y) + (v[j].z + v[j].w); }
            const float mean = wave_sum(s) * (1.f / D); float s2 = 0.f;
#pragma unroll
            for (int j = 0; j < 4; ++j) { v[j] = v[j] - mean; s2 += (v[j].x * v[j].x + v[j].y * v[j].y) + (v[j].z * v[j].z + v[j].w * v[j].w); }
            const float rstd = 1.f / sqrtf(wave_sum(s2) * (1.f / D) + LN_EPS);
#pragma unroll
            for (int j = 0; j < 4; ++j) { const f32x4 gg = ((const f32x4*)a.in[I_LN1G])[64 * j + lane], bb = ((const f32x4*)a.in[I_LN1B])[64 * j + lane];
                v[j] = v[j] * rstd * gg + bb;
                ((f32x4*)srow)[64 * j + lane] = v[j];
                ((unsigned long long*)(H1B + (size_t)token * D))[64 * j + lane] = (unsigned long long)pk2(v[j].x, v[j].y) | ((unsigned long long)pk2(v[j].z, v[j].w) << 32); }
            float lg[32];
#pragma unroll
            for (int e = 0; e < 32; ++e) { float p = 0.f;
#pragma unroll
                for (int j = 0; j < 4; ++j) { const f32x4 w = *(const LAS f32x4*)(WRT + e * 1024 + 256 * j + 4 * lane); p += (v[j].x * w.x + v[j].y * w.y) + (v[j].z * w.z + v[j].w * w.w); }
                lg[e] = wave_sum(p) + a.in[I_BR][e]; }
            int te[4]; float tv[4];
#pragma unroll
            for (int k = 0; k < 4; ++k) { float best = -3.0e38f; int bi = 0;
#pragma unroll
                for (int e = 0; e < 32; ++e) { const bool taken = (k > 0 && te[0] == e) || (k > 1 && te[1] == e) || (k > 2 && te[2] == e); if (!taken && lg[e] > best) { best = lg[e]; bi = e; } }
                te[k] = bi; tv[k] = best; }
            const float e0 = 1.0f, e1 = __expf(tv[1] - tv[0]), e2 = __expf(tv[2] - tv[0]), e3 = __expf(tv[3] - tv[0]); const float inv = 1.0f / (e0 + e1 + e2 + e3);
            if (lane < 4) { const int k = lane; const int e = k == 0 ? te[0] : k == 1 ? te[1] : k == 2 ? te[2] : te[3]; const float g = (k == 0 ? e0 : k == 1 ? e1 : k == 2 ? e2 : e3) * inv;
                const int lp = atomicAdd((int*)(cntL + e), 1);
                tokE[tokl * 4 + k] = e; tokP[tokl * 4 + k] = lp; SG[(size_t)token * 4 + k] = g; }
        }
        __syncthreads();
        if (tid < 32) baseL[tid] = (int)__hip_atomic_fetch_add(cnt + tid, (unsigned)cntL[tid], RLX_AGENT);
        __syncthreads();
        if (tid < 256) { const int e = tokE[tid]; ROWTOK[(size_t)e * M + baseL[e] + tokP[tid]] = (blk * 64) * 4 + tid; }
        __syncthreads();
    }
}

__device__ __forceinline__ void moe_table(const Args& a, Frame& F, LAS int* tstart, LAS int* cntl) {
    const unsigned* cnt = (const unsigned*)(a.ws + WS_CTL) + CW_CNT;
    if (F.tid < 32) cntl[F.tid] = (int)__hip_atomic_load(cnt + F.tid, RLX_AGENT);
    __syncthreads();
    if (F.tid == 0) { int s = 0; for (int e = 0; e < 32; ++e) { tstart[e] = s; s += (cntl[e] + 255) >> 8; } tstart[32] = s; }
    __syncthreads();
}

__device__ __forceinline__ void gather_phase(const Args& a, Frame& F, const LAS int* tstart, const LAS int* cntl) {
    unsigned char* ws = a.ws;
    const bf16* H1B = (const bf16*)(ws + WS_H1B); bf16* XS = (bf16*)(ws + WS_XS); const int* ROWTOK = (const int*)(ws + WS_ROWTOK);
    const int gw = F.vcu * NWAVES + F.wave, NGW = F.G * NWAVES; const int total = tstart[32] * 256;
    for (int R = gw; R < total; R += NGW) {
        const int tile = R >> 8; int e = 0; while (e < 31 && tile >= tstart[e + 1]) ++e;
        const int p = R - tstart[e] * 256; int tok = M;
        if (p < cntl[e]) tok = ROWTOK[(size_t)e * M + p] >> 2;
        const v4u* s = (const v4u*)(H1B + (size_t)tok * D); v4u* d = (v4u*)(XS + (size_t)R * D);
        d[F.lane] = s[F.lane]; d[F.lane + 64] = s[F.lane + 64];
    }
}

__device__ __forceinline__ void final_phase(const Args& a, Frame& F) {
    unsigned char* ws = a.ws;
    const float* H1F = (const float*)(ws + WS_H1F); const bf16* Y = (const bf16*)(ws + WS_Y);
    const int gw = F.vcu * NWAVES + F.wave, NGW = F.G * NWAVES, lane = F.lane;
    for (int token = gw; token < M; token += NGW) {
        f32x4 v[4]; float s = 0.f;
#pragma unroll
        for (int j = 0; j < 4; ++j) { v[j] = ((const f32x4*)(H1F + (size_t)token * D))[64 * j + lane] * DN_ALPHA;
#pragma unroll
            for (int k = 0; k < 4; ++k) { const v2u w = ((const v2u*)(Y + ((size_t)token * 4 + k) * D))[64 * j + lane]; v[j] = v[j] + (f32x4){bflo(w.x), bfhi(w.x), bflo(w.y), bfhi(w.y)}; }
            s += (v[j].x + v[j].y) + (v[j].z + v[j].w); }
        const float mean = wave_sum(s) * (1.f / D); float s2 = 0.f;
#pragma unroll
        for (int j = 0; j < 4; ++j) { v[j] = v[j] - mean; s2 += (v[j].x * v[j].x + v[j].y * v[j].y) + (v[j].z * v[j].z + v[j].w * v[j].w); }
        const float rstd = 1.f / sqrtf(wave_sum(s2) * (1.f / D) + LN_EPS);
#pragma unroll
        for (int j = 0; j < 4; ++j) { const f32x4 gg = ((const f32x4*)a.in[I_LN2G])[64 * j + lane], bb = ((const f32x4*)a.in[I_LN2B])[64 * j + lane];
            ((f32x4*)(a.out + (size_t)token * D))[64 * j + lane] = v[j] * rstd * gg + bb; }
    }
}

#ifndef MK_MULTI
#define MK_MULTI 0
#endif
constexpr int N_PHASES = 12;

__global__ void __launch_bounds__(NTHR, 2) fwd_kernel(Args a) {
    extern __shared__ __attribute__((aligned(16))) unsigned char lds_raw[];
    Frame F;
    F.lds = (LAS unsigned char*)lds_raw;
    F.tid = threadIdx.x; F.lane = F.tid & 63; F.wave = __builtin_amdgcn_readfirstlane(F.tid >> 6);
    F.G = gridDim.x; F.bid = blockIdx.x; F.vcu = (F.G % 8 == 0) ? (F.bid % 8) * (F.G / 8) + F.bid / 8 : F.bid;
    unsigned char* ws = a.ws;
    LAS int* tstart = (LAS int*)(F.lds + LDSCTL_OFF); LAS int* cntl = tstart + 40;
    const int lo = a.ph_lo, hi = a.ph_hi;
#define IN(k) (lo <= (k) && (k) < hi)
#if MK_MULTI
#define SEAM(k) do { } while (0)
#else
#define SEAM(k) do { if (IN(k) && IN((k) + 1)) { cg::this_grid().sync(); } } while (0)
#endif
    if (IN(0)) { p0_prologue(a, F); } SEAM(0);
    if (IN(1)) {
        pg8::Gemm g{(const bf16*)(ws + WS_XN), (const bf16*)(ws + WS_WINT), MA1, NB1, D};
        ProjOrder S; S.init(M, NPROJ, F.G, F.bid);
        EpiProj E{(const float*)(ws + WS_BIASP), ws};
        pg8::gemm_phase<EpiProj, ProjOrder, true, true>(F.lds + RING_OFF, g, S, E);
    } SEAM(1);
    if (IN(2)) { dsa_phase(a, F); __syncthreads(); conv_phase(a, F); __syncthreads(); memattn_phase(a, F); } SEAM(2);
    if (IN(3)) {
        { pg8::Gemm g{(const bf16*)(ws + WS_OLAT), (const bf16*)(ws + WS_WOAT), M, D, D}; StaticOrder S; S.init(M, D, F.G, F.bid); EpiMix<0> E{nullptr, ws};
          pg8::gemm_phase<EpiMix<0>, StaticOrder, false, true>(F.lds + RING_OFF, g, S, E); }
        { pg8::Gemm g{(const bf16*)(ws + WS_UB), (const bf16*)(ws + WS_WPW2T), M, D, 512}; StaticOrder S; S.init(M, D, F.G, F.bid); EpiMix<1> E{a.in[I_BPW2], ws};
          pg8::gemm_phase<EpiMix<1>, StaticOrder, false, true>(F.lds + RING_OFF, g, S, E); }
        { pg8::Gemm g{(const bf16*)(ws + WS_OC), (const bf16*)(ws + WS_WOCT), M, D, 512}; StaticOrder S; S.init(M, D, F.G, F.bid); EpiMix<2> E{nullptr, ws};
          pg8::gemm_phase<EpiMix<2>, StaticOrder, false, true>(F.lds + RING_OFF, g, S, E); }
    } SEAM(3);
    if (IN(4)) {
        pg8::Gemm g{(const bf16*)(ws + WS_MIX), (const bf16*)(ws + WS_WOUTT), M, D, D}; StaticOrder S; S.init(M, D, F.G, F.bid); EpiOut E{a.in[I_BOUT], ws};
        pg8::gemm_phase<EpiOut, StaticOrder, false, true>(F.lds + RING_OFF, g, S, E);
    } SEAM(4);
    if (IN(5)) { router_phase(a, F); } SEAM(5);
    if (IN(6)) { moe_table(a, F, tstart, cntl); gather_phase(a, F, tstart, cntl); } SEAM(6);
    if (IN(7)) {
        moe_table(a, F, tstart, cntl);
        pg8::Gemm g{(const bf16*)(ws + WS_XS), (const bf16*)(ws + WS_W1T), MAXTILES * 256, NEXP * 2048, D};
        MoeOrder<8> S{tstart, F.G, F.vcu}; EpiMoe1 E{a.in[I_B1], ws};
        pg8::gemm_phase<EpiMoe1, MoeOrder<8>, true, true>(F.lds + RING_OFF, g, S, E);
    } SEAM(7);
    if (IN(8)) {
        moe_table(a, F, tstart, cntl);
        pg8::Gemm g{(const bf16*)(ws + WS_HMID), (const bf16*)(ws + WS_W2T), MAXTILES * 256, NEXP * 1024, FF};
        MoeOrder<4> S{tstart, F.G, F.vcu}; EpiMoe2 E{a.in[I_B2], ws, tstart, cntl};
        pg8::gemm_phase<EpiMoe2, MoeOrder<4>, true, true>(F.lds + RING_OFF, g, S, E);
    } SEAM(8);
    if (IN(9)) { final_phase(a, F); }
#undef IN
#undef SEAM
}

extern "C" void kernel_launch(void* const* d_in, const int* in_sizes, int n_in, void* d_out, int out_size, void* d_ws, size_t ws_size, hipStream_t stream) {
    static int grid = 0;
    if (grid == 0) {
        if (n_in != N_IN || out_size != M * D || ws_size < WS_END) { fprintf(stderr, "kernel_launch: unexpected shapes (n_in %d, out %d, ws %zu); nothing launched\n", n_in, out_size, ws_size); grid = -1; return; }
        int dev = 0, cus = 0, per_cu = 0;
        if (hipGetDevice(&dev) != hipSuccess || hipDeviceGetAttribute(&cus, hipDeviceAttributeMultiprocessorCount, dev) != hipSuccess) { grid = -1; return; }
        if (hipFuncSetAttribute((const void*)fwd_kernel, hipFuncAttributeMaxDynamicSharedMemorySize, LDS_BYTES) != hipSuccess) { fprintf(stderr, "kernel_launch: hipFuncSetAttribute failed\n"); grid = -1; return; }
        if (hipOccupancyMaxActiveBlocksPerMultiprocessor(&per_cu, (const void*)fwd_kernel, NTHR, LDS_BYTES) != hipSuccess || per_cu < 1) { fprintf(stderr, "kernel_launch: occupancy query failed (%d)\n", per_cu); (void)hipGetLastError(); grid = -1; return; }
        grid = cus;
    }
    if (grid < 0) return;
    (void)hipMemsetAsync((char*)d_ws + WS_CTL, 0, CTL_ZERO_BYTES, stream);
    Args a{};
    for (int i = 0; i < N_IN; ++i) a.in[i] = (const float*)d_in[i];
    a.out = (float*)d_out; a.ws = (unsigned char*)d_ws;
#if MK_MULTI
    for (int p = 0; p < 10; ++p) { a.ph_lo = p; a.ph_hi = p + 1; hipLaunchKernelGGL(fwd_kernel, dim3(grid), dim3(NTHR), LDS_BYTES, stream, a); }
#else
    a.ph_lo = 0; a.ph_hi = 10;
    void* args[] = {&a};
    hipError_t e = hipLaunchCooperativeKernel((const void*)fwd_kernel, dim3(grid), dim3(NTHR), args, LDS_BYTES, stream);
    if (e != hipSuccess) fprintf(stderr, "kernel_launch: cooperative launch failed: %s (grid %d)\n", hipGetErrorString(e), grid);
#endif
}
```
